# Optimizing an MI355X kernel written in HIP

```python
import math
import numpy as np
import jax
import jax.numpy as jnp
from jax import lax

D_MODEL = 1024
BATCH = 2
SEQ = 8192
DEPTH = 2

HEAD_DIM = 64
N_HEADS = D_MODEL // HEAD_DIM
HEADS_PER_MIXER = N_HEADS // 4
GROUP_W = HEADS_PER_MIXER * HEAD_DIM
D_MIX = 4 * GROUP_W
D_FF = 2816
Q_BLOCK = 128
ROPE_THETA = 10000.0
LN_EPS = 1e-5
NORM_EPS = 1e-6
NEG = -1e30
DIFF_QK_DIM = HEAD_DIM // 2
GDN_CONV = 4
GDN_CHUNK = 64
CMP_BLOCK = 32
CMP_STRIDE = 16
CMP_HIDDEN = 256
SLC_BLOCK = 64
SLC_TOPN = 16
WINDOW = 512
FORCE = 1e4
PROJ_SIZES = ((HEADS_PER_MIXER * DIFF_QK_DIM,) * 4 + (GROUP_W,)
              + (GROUP_W,) * 4 + (HEADS_PER_MIXER,) * 2
              + (GROUP_W,) + (HEAD_DIM,) * 6 + (3 * HEADS_PER_MIXER,)
              + (GROUP_W,) * 3)
P_TOTAL = sum(PROJ_SIZES)

kernel_name = 'hybrid_parallel_head_groups_block'


def _layer_norm(x, g, b):
    x32 = x.astype(jnp.float32)
    mu = jnp.mean(x32, axis=-1, keepdims=True)
    var = jnp.mean(jnp.square(x32 - mu), axis=-1, keepdims=True)
    return ((x32 - mu) * lax.rsqrt(var + LN_EPS) * g + b).astype(x.dtype)


def _rms_norm(x, g):
    x32 = x.astype(jnp.float32)
    y = x32 * lax.rsqrt(jnp.mean(jnp.square(x32), axis=-1, keepdims=True) + NORM_EPS) * g
    return y.astype(x.dtype)


def _l2norm(x):
    return x * lax.rsqrt(jnp.sum(x * x, axis=-1, keepdims=True) + NORM_EPS)


def _swiglu(x, w_gu, w_down):
    g, u = jnp.split(x @ w_gu, 2, axis=-1)
    return (jax.nn.silu(g) * u) @ w_down


def _to_heads(t, n):
    B, S, _ = t.shape
    return t.reshape(B, S, n, -1).transpose(0, 2, 1, 3)


def _from_heads(t):
    B, H, S, d = t.shape
    return t.transpose(0, 2, 1, 3).reshape(B, S, H * d)


def _unblock(o):
    n, B, H, Q, d = o.shape
    return o.transpose(1, 2, 0, 3, 4).reshape(B, H, n * Q, d)


def _rope_tables(seq, dim):
    inv = ROPE_THETA ** (-jnp.arange(0, dim, 2, dtype=jnp.float32) / dim)
    ang = jnp.arange(seq, dtype=jnp.float32)[:, None] * inv[None, :]
    return jnp.cos(ang), jnp.sin(ang)


def _rope(t, cs):
    cos, sin = cs[0].astype(t.dtype), cs[1].astype(t.dtype)
    t1, t2 = jnp.split(t, 2, axis=-1)
    return jnp.concatenate([t1 * cos - t2 * sin, t2 * cos + t1 * sin], axis=-1)


def _causal_dwconv(x, w):
    K = w.shape[0]
    return lax.conv_general_dilated(x, w[:, None, :], window_strides=(1,), padding=((K - 1, 0),),
                                    dimension_numbers=('NWC', 'WIO', 'NWC'),
                                    feature_group_count=x.shape[-1])


def diff_attention(q1, q2, k1, k2, v, lam_q1, lam_k1, lam_q2, lam_k2, subln_g, lam_init):
    f32 = jnp.float32
    B, H, S, dq = q1.shape
    scale = dq ** -0.5
    lam = (jnp.exp(jnp.sum(lam_q1.astype(f32) * lam_k1.astype(f32)))
           - jnp.exp(jnp.sum(lam_q2.astype(f32) * lam_k2.astype(f32))) + lam_init)
    kpos = jnp.arange(S)

    def block(i):
        start = i * Q_BLOCK
        qpos = start + jnp.arange(Q_BLOCK)
        causal = kpos[None, :] <= qpos[:, None]

        def probs(q, k):
            qb = lax.dynamic_slice_in_dim(q, start, Q_BLOCK, axis=2)
            s = jnp.einsum('bhqd,bhkd->bhqk', qb, k).astype(f32) * scale
            return jax.nn.softmax(jnp.where(causal, s, NEG), axis=-1)

        w = probs(q1, k1) - lam * probs(q2, k2)
        return jnp.einsum('bhqk,bhkd->bhqd', w.astype(v.dtype), v)

    o = _unblock(lax.map(block, jnp.arange(S // Q_BLOCK)))
    return _from_heads(_rms_norm(o, subln_g) * (1.0 - lam_init))


def gated_delta_net(q, k, v, z, a, b, conv_w, a_log, dt_bias, norm_g):
    f32 = jnp.float32
    B, S, _ = q.shape
    H, d, C = HEADS_PER_MIXER, HEAD_DIM, GDN_CHUNK
    N = S // C
    qkv = jax.nn.silu(_causal_dwconv(jnp.concatenate([q, k, v], axis=-1), conv_w))
    q, k, v = [_to_heads(t, H).astype(f32) for t in jnp.split(qkv, 3, axis=-1)]
    q = _l2norm(q) * d ** -0.5
    k = _l2norm(k)
    beta = jax.nn.sigmoid(b.astype(f32)).transpose(0, 2, 1)
    g = (-jnp.exp(a_log.astype(f32))[None, :, None]
         * jax.nn.softplus(a.astype(f32).transpose(0, 2, 1) + dt_bias.astype(f32)[None, :, None]))

    def chunk(t):
        return t.reshape((B, H, N, C) + t.shape[3:])

    q, k, v, beta, g = chunk(q), chunk(k), chunk(v), chunk(beta), chunk(g)
    G = jnp.cumsum(g, axis=-1)
    tri = jnp.tril(jnp.ones((C, C), bool))
    strict = jnp.tril(jnp.ones((C, C), bool), -1)
    decay = jnp.exp(jnp.where(tri, G[..., :, None] - G[..., None, :], -jnp.inf))
    kb = k * beta[..., None]
    A = jnp.where(strict, jnp.einsum('bhncd,bhnsd->bhncs', kb, k) * decay, 0.0)
    lhs = A + jnp.eye(C, dtype=f32)
    rhs = jnp.concatenate([v * beta[..., None], kb * jnp.exp(G)[..., None]], axis=-1)
    sol = lax.linalg.triangular_solve(lhs, rhs, left_side=True, lower=True, unit_diagonal=True)
    u, w = jnp.split(sol, 2, axis=-1)
    intra = jnp.einsum('bhncd,bhnsd->bhncs', q, k) * decay
    q_dec = q * jnp.exp(G)[..., None]
    k_dec = k * jnp.exp(G[..., -1:] - G)[..., None]
    g_last = jnp.exp(G[..., -1])

    def step(state, inp):
        u_n, w_n, qd_n, kd_n, in_n, gl_n = inp
        v_new = u_n - jnp.einsum('bhcd,bhde->bhce', w_n, state)
        o_n = (jnp.einsum('bhcd,bhde->bhce', qd_n, state)
               + jnp.einsum('bhcs,bhse->bhce', in_n, v_new))
        state = state * gl_n[..., None, None] + jnp.einsum('bhcd,bhce->bhde', kd_n, v_new)
        return state, o_n

    xs = tuple(jnp.moveaxis(t, 2, 0) for t in (u, w, q_dec, k_dec, intra, g_last))
    _, o = lax.scan(step, jnp.zeros((B, H, d, d), f32), xs)
    o = _rms_norm(_unblock(o), norm_g) * jax.nn.silu(_to_heads(z, H).astype(f32))
    return _from_heads(o).astype(z.dtype)


def native_sparse_attention(q, kc, vc, ks, vs, kw, vw, gate, pe_k, pe_v,
                            ck_w1, ck_w2, cv_w1, cv_w2, rope_n):
    f32 = jnp.float32
    B, S, _ = q.shape
    H, d = HEADS_PER_MIXER, HEAD_DIM
    scale = d ** -0.5
    q = _rope(_to_heads(q, H), rope_n)
    kc, ks, kw = _rope(kc, rope_n), _rope(ks, rope_n), _rope(kw, rope_n)
    tpos = jnp.arange(S)

    n_cmp = (S - CMP_BLOCK) // CMP_STRIDE + 1
    cidx = np.arange(n_cmp)[:, None] * CMP_STRIDE + np.arange(CMP_BLOCK)[None, :]

    def compress(t, pe, w1, w2):
        blk = (t[:, cidx, :] + pe).reshape(B, n_cmp, CMP_BLOCK * d)
        return jax.nn.silu(blk @ w1) @ w2

    k_cmp = compress(kc, pe_k, ck_w1, ck_w2)
    v_cmp = compress(vc, pe_v, cv_w1, cv_w2)
    cmask = jnp.asarray(cidx[:, -1])[None, :] <= tpos[:, None]
    s_cmp = jnp.einsum('bhtd,bcd->bhtc', q, k_cmp).astype(f32) * scale
    p_cmp = jax.nn.softmax(jnp.where(cmask, s_cmp, NEG), axis=-1) * cmask
    o_cmp = jnp.einsum('bhtc,bcd->bhtd', p_cmp.astype(v_cmp.dtype), v_cmp)

    n_slc = S // SLC_BLOCK
    sstart = np.arange(n_slc) * SLC_BLOCK
    overlap = (cidx[:, :1] < sstart[None, :] + SLC_BLOCK) & (cidx[:, -1:] >= sstart[None, :])
    imp = jnp.einsum('btc,cj->btj', p_cmp.sum(axis=1), jnp.asarray(overlap, f32))
    blk = jnp.arange(n_slc)[None, :]
    cur = (tpos // SLC_BLOCK)[:, None]
    valid = blk <= cur
    forced = valid & ((blk == 0) | (blk == cur) | (blk == cur - 1))
    imp = jnp.where(forced, FORCE, jnp.where(valid, imp, -FORCE))
    _, sel = lax.top_k(imp, min(SLC_TOPN, n_slc))

    ks_blk = ks.reshape(B, n_slc, SLC_BLOCK, d)
    vs_blk = vs.reshape(B, n_slc, SLC_BLOCK, d)
    kw_pad = jnp.pad(kw, ((0, 0), (WINDOW, 0), (0, 0)))
    vw_pad = jnp.pad(vw, ((0, 0), (WINDOW, 0), (0, 0)))
    gather = jax.vmap(lambda tb, ib: tb[ib])

    def block(i):
        start = i * Q_BLOCK
        qb = lax.dynamic_slice_in_dim(q, start, Q_BLOCK, axis=2)
        qpos = start + jnp.arange(Q_BLOCK)
        sel_b = lax.dynamic_slice_in_dim(sel, start, Q_BLOCK, axis=1)
        kg = gather(ks_blk, sel_b).reshape(B, Q_BLOCK, -1, d)
        vg = gather(vs_blk, sel_b).reshape(B, Q_BLOCK, -1, d)
        kpos = (sel_b[..., None] * SLC_BLOCK + jnp.arange(SLC_BLOCK)).reshape(B, Q_BLOCK, -1)
        smask = (kpos <= qpos[None, :, None])[:, None]
        ss = jnp.einsum('bhqd,bqkd->bhqk', qb, kg).astype(f32) * scale
        ps = jax.nn.softmax(jnp.where(smask, ss, NEG), axis=-1)
        o_s = jnp.einsum('bhqk,bqkd->bhqd', ps.astype(vg.dtype), vg)
        kwin = lax.dynamic_slice_in_dim(kw_pad, start, Q_BLOCK + WINDOW, axis=1)
        vwin = lax.dynamic_slice_in_dim(vw_pad, start, Q_BLOCK + WINDOW, axis=1)
        wpos = start - WINDOW + jnp.arange(Q_BLOCK + WINDOW)
        rel = qpos[:, None] - wpos[None, :]
        wmask = (rel >= 0) & (rel < WINDOW) & (wpos[None, :] >= 0)
        sw = jnp.einsum('bhqd,bkd->bhqk', qb, kwin).astype(f32) * scale
        pw = jax.nn.softmax(jnp.where(wmask, sw, NEG), axis=-1)
        o_w = jnp.einsum('bhqk,bkd->bhqd', pw.astype(vwin.dtype), vwin)
        return o_s, o_w

    o_sel, o_win = lax.map(block, jnp.arange(S // Q_BLOCK))
    o_sel, o_win = _unblock(o_sel), _unblock(o_win)
    gts = jax.nn.sigmoid(gate).reshape(B, S, H, 3).transpose(0, 2, 1, 3)
    o = gts[..., 0:1] * o_cmp + gts[..., 1:2] * o_sel + gts[..., 2:3] * o_win
    return _from_heads(o)


def stick_breaking(q, k, v):
    f32 = jnp.float32
    H = HEADS_PER_MIXER
    q, k, v = _to_heads(q, H), _to_heads(k, H), _to_heads(v, H)
    B, _, S, d = q.shape
    scale = d ** -0.5
    kpos = jnp.arange(S)

    def block(i):
        start = i * Q_BLOCK
        qb = lax.dynamic_slice_in_dim(q, start, Q_BLOCK, axis=2)
        qpos = start + jnp.arange(Q_BLOCK)
        before = kpos[None, :] < qpos[:, None]
        z = jnp.einsum('bhqd,bhkd->bhqk', qb, k).astype(f32) * scale
        log_keep = jnp.where(before, jax.nn.log_sigmoid(-z), 0.0)
        between = lax.cumsum(log_keep, axis=3, reverse=True) - log_keep
        att = jnp.where(before, jnp.exp(jax.nn.log_sigmoid(z) + between), 0.0)
        return jnp.einsum('bhqk,bhkd->bhqd', att.astype(v.dtype), v)

    return _from_heads(_unblock(lax.map(block, jnp.arange(S // Q_BLOCK))))


def hybrid_mixer(x, w_in, w_out, lam_q1, lam_k1, lam_q2, lam_k2, subln_g,
                 conv_w, a_log, dt_bias, gdn_g, pe_k, pe_v, ck_w1, ck_w2, cv_w1, cv_w2,
                 lam_init, rope_d, rope_n):
    H = HEADS_PER_MIXER
    (dq1, dq2, dk1, dk2, dv, gq, gk, gv, gz, ga, gb,
     nq, nkc, nvc, nks, nvs, nkw, nvw, ngate, sq, sk, sv) = jnp.split(
        x @ w_in, np.cumsum(PROJ_SIZES)[:-1].tolist(), axis=-1)
    o_diff = diff_attention(_rope(_to_heads(dq1, H), rope_d), _rope(_to_heads(dq2, H), rope_d),
                            _rope(_to_heads(dk1, H), rope_d), _rope(_to_heads(dk2, H), rope_d),
                            _to_heads(dv, H), lam_q1, lam_k1, lam_q2, lam_k2, subln_g, lam_init)
    o_gdn = gated_delta_net(gq, gk, gv, gz, ga, gb, conv_w, a_log, dt_bias, gdn_g)
    o_nsa = native_sparse_attention(nq, nkc, nvc, nks, nvs, nkw, nvw, ngate, pe_k, pe_v,
                                    ck_w1, ck_w2, cv_w1, cv_w2, rope_n)
    o_sb = stick_breaking(sq, sk, sv)
    return jnp.concatenate([o_diff, o_gdn, o_nsa, o_sb], axis=-1) @ w_out


def setup_inputs(seed: int = 0) -> dict:
    key = jax.random.key(seed)
    ks = iter(jax.random.split(key, 48))
    L, H = DEPTH, HEADS_PER_MIXER
    beta_dn = (8 * DEPTH) ** -0.25

    def nrm(shape, scale):
        return jax.random.normal(next(ks), shape, jnp.float32) * scale

    def gain(shape):
        return 1.0 + nrm(shape, 0.02)

    x = nrm((BATCH, SEQ, D_MODEL), 1.0)
    w_in = nrm((L, D_MODEL, P_TOTAL), D_MODEL ** -0.5)
    w_out = nrm((L, D_MIX, D_MODEL), beta_dn * D_MIX ** -0.5)
    ffn1_w_gu = nrm((L, D_MODEL, 2 * D_FF), D_MODEL ** -0.5)
    ffn1_w_down = nrm((L, D_FF, D_MODEL), beta_dn * D_FF ** -0.5)
    ffn2_w_gu = nrm((L, D_MODEL, 2 * D_FF), D_MODEL ** -0.5)
    ffn2_w_down = nrm((L, D_FF, D_MODEL), beta_dn * D_FF ** -0.5)
    ln1_g, ln1_b = gain((L, D_MODEL)), nrm((L, D_MODEL), 0.02)
    ln2_g, ln2_b = gain((L, D_MODEL)), nrm((L, D_MODEL), 0.02)
    ln3_g, ln3_b = gain((L, D_MODEL)), nrm((L, D_MODEL), 0.02)
    diff_lam_q1 = nrm((L, DIFF_QK_DIM), 0.1)
    diff_lam_k1 = nrm((L, DIFF_QK_DIM), 0.1)
    diff_lam_q2 = nrm((L, DIFF_QK_DIM), 0.1)
    diff_lam_k2 = nrm((L, DIFF_QK_DIM), 0.1)
    diff_subln_g = gain((L, HEAD_DIM))
    gdn_conv_w = nrm((L, GDN_CONV, 3 * GROUP_W), GDN_CONV ** -0.5)
    gdn_a_log = jnp.log(jax.random.uniform(next(ks), (L, H), jnp.float32, 1.0, 16.0))
    dt = jnp.exp(jax.random.uniform(next(ks), (L, H), jnp.float32, math.log(1e-3), math.log(1e-1)))
    gdn_dt_bias = dt + jnp.log(-jnp.expm1(-dt))
    gdn_norm_g = gain((L, HEAD_DIM))
    nsa_pe_k = nrm((L, CMP_BLOCK, HEAD_DIM), 0.02)
    nsa_pe_v = nrm((L, CMP_BLOCK, HEAD_DIM), 0.02)
    nsa_cmp_k_w1 = nrm((L, CMP_BLOCK * HEAD_DIM, CMP_HIDDEN), (CMP_BLOCK * HEAD_DIM) ** -0.5)
    nsa_cmp_k_w2 = nrm((L, CMP_HIDDEN, HEAD_DIM), CMP_HIDDEN ** -0.5)
    nsa_cmp_v_w1 = nrm((L, CMP_BLOCK * HEAD_DIM, CMP_HIDDEN), (CMP_BLOCK * HEAD_DIM) ** -0.5)
    nsa_cmp_v_w2 = nrm((L, CMP_HIDDEN, HEAD_DIM), CMP_HIDDEN ** -0.5)
    return {'x': x, 'w_in': w_in, 'w_out': w_out,
            'ffn1_w_gu': ffn1_w_gu, 'ffn1_w_down': ffn1_w_down,
            'ffn2_w_gu': ffn2_w_gu, 'ffn2_w_down': ffn2_w_down,
            'ln1_g': ln1_g, 'ln1_b': ln1_b, 'ln2_g': ln2_g, 'ln2_b': ln2_b,
            'ln3_g': ln3_g, 'ln3_b': ln3_b,
            'diff_lam_q1': diff_lam_q1, 'diff_lam_k1': diff_lam_k1,
            'diff_lam_q2': diff_lam_q2, 'diff_lam_k2': diff_lam_k2, 'diff_subln_g': diff_subln_g,
            'gdn_conv_w': gdn_conv_w, 'gdn_a_log': gdn_a_log, 'gdn_dt_bias': gdn_dt_bias,
            'gdn_norm_g': gdn_norm_g,
            'nsa_pe_k': nsa_pe_k, 'nsa_pe_v': nsa_pe_v,
            'nsa_cmp_k_w1': nsa_cmp_k_w1, 'nsa_cmp_k_w2': nsa_cmp_k_w2,
            'nsa_cmp_v_w1': nsa_cmp_v_w1, 'nsa_cmp_v_w2': nsa_cmp_v_w2}


def reference(x, w_in, w_out, ffn1_w_gu, ffn1_w_down, ffn2_w_gu, ffn2_w_down,
              ln1_g, ln1_b, ln2_g, ln2_b, ln3_g, ln3_b,
              diff_lam_q1, diff_lam_k1, diff_lam_q2, diff_lam_k2, diff_subln_g,
              gdn_conv_w, gdn_a_log, gdn_dt_bias, gdn_norm_g,
              nsa_pe_k, nsa_pe_v, nsa_cmp_k_w1, nsa_cmp_k_w2, nsa_cmp_v_w1, nsa_cmp_v_w2):
    S = x.shape[1]
    alpha = (2 * DEPTH) ** 0.25
    rope_d = _rope_tables(S, DIFF_QK_DIM)
    rope_n = _rope_tables(S, HEAD_DIM)
    for l in range(DEPTH):
        lam_init = 0.8 - 0.6 * math.exp(-0.3 * l)
        x = _layer_norm(alpha * x + 0.5 * _swiglu(x, ffn1_w_gu[l], ffn1_w_down[l]), ln1_g[l], ln1_b[l])
        mix = hybrid_mixer(x, w_in[l], w_out[l], diff_lam_q1[l], diff_lam_k1[l], diff_lam_q2[l],
                           diff_lam_k2[l], diff_subln_g[l], gdn_conv_w[l], gdn_a_log[l],
                           gdn_dt_bias[l], gdn_norm_g[l], nsa_pe_k[l], nsa_pe_v[l],
                           nsa_cmp_k_w1[l], nsa_cmp_k_w2[l], nsa_cmp_v_w1[l], nsa_cmp_v_w2[l],
                           lam_init, rope_d, rope_n)
        x = _layer_norm(alpha * x + mix, ln2_g[l], ln2_b[l])
        x = _layer_norm(alpha * x + 0.5 * _swiglu(x, ffn2_w_gu[l], ffn2_w_down[l]), ln3_g[l], ln3_b[l])
    return x
```

```cpp
#include <hip/hip_runtime.h>
#include <hip/hip_cooperative_groups.h>
#include <stdint.h>
#include <cstdio>
namespace cg = cooperative_groups;

#ifndef MK_COOP
#define MK_COOP 1
#endif

#define DI __device__ __forceinline__
typedef unsigned short bf16_t;
typedef short bf16x8 __attribute__((ext_vector_type(8)));
typedef short s16x4 __attribute__((ext_vector_type(4)));
typedef float f32x4 __attribute__((ext_vector_type(4)));
typedef float f32x16 __attribute__((ext_vector_type(16)));
typedef unsigned u32x4 __attribute__((ext_vector_type(4)));

constexpr int T_ = 16384, S_ = 8192, D_ = 1024, DFF = 2816, LDP = 3328;
constexpr int VLD = T_ + 128;
constexpr int CLD = 544;
constexpr int C_DQ1 = 0, C_DQ2 = 128, C_DK1 = 256, C_DK2 = 384, C_DV = 512, C_GQ = 768, C_GK = 1024, C_GV = 1280, C_GZ = 1536,
              C_NQ = 1792, C_NKC = 2048, C_NVC = 2112, C_NKS = 2176, C_NVS = 2240, C_NKW = 2304, C_NVW = 2368,
              C_SQ = 2432, C_SK = 2688, C_SV = 2944, C_GA = 3200, C_GB = 3204, C_NG = 3208;

constexpr size_t OFF_GU = 0, OFF_DN = 11534336, OFF_WIN = OFF_DN + 5767168, OFF_WOUT = OFF_WIN + 6815744;
constexpr size_t OFF_VT = 0;
constexpr size_t OFF_XB = OFF_WOUT + 2097152;
constexpr size_t OFF_BIG = OFF_XB + 33554432;
constexpr size_t OFF_GU_ = OFF_BIG + 109051904;
constexpr size_t OFF_GW = OFF_GU_ + 16777216, OFF_GKD = OFF_GW + 16777216, OFF_GS = OFF_GKD + 16777216;
constexpr size_t OFF_OWIN = OFF_GS + 16777216;
constexpr size_t OFF_ROPE = OFF_OWIN + 8388608;
constexpr size_t OFF_KCMP = OFF_ROPE + 3145728, OFF_VCMP = OFF_KCMP + 262144;
constexpr size_t OFF_GLAST = OFF_VCMP + 262144;
constexpr size_t OFF_CNT = OFF_GLAST + 4096;
constexpr size_t OFF_BAR = OFF_CNT + 512;
constexpr size_t WS_NEED = OFF_BAR + 32768;

struct Params {
  const float *x, *w_in, *w_out, *gu1, *dn1, *gu2, *dn2;
  const float *ln1g, *ln1b, *ln2g, *ln2b, *ln3g, *ln3b;
  const float *lq1, *lk1, *lq2, *lk2, *subln;
  const float *convw, *alog, *dtb, *gdng;
  const float *pek, *pev, *ckw1, *ckw2, *cvw1, *cvw2;
  float* out; char* ws;
};

DI int tid_() { int t = __builtin_amdgcn_workitem_id_x(); asm volatile("" : "+v"(t)); return t; }
DI float bf2f(bf16_t v) { return __uint_as_float(((unsigned)v) << 16); }
DI bf16_t f2bf(float f) { unsigned u = __float_as_uint(f); u += 0x7fffu + ((u >> 16) & 1u); return (bf16_t)(u >> 16); }
DI unsigned pack2(float a, float b) { return (unsigned)f2bf(a) | ((unsigned)f2bf(b) << 16); }
DI float fexp2(float x) { return __builtin_amdgcn_exp2f(x); }
DI float fexp(float x) { return __builtin_amdgcn_exp2f(x * 1.4426950408889634f); }
DI float flog(float x) { return __builtin_amdgcn_logf(x) * 0.6931471805599453f; }
DI float wave_max(float v) { for (int o = 32; o >= 1; o >>= 1) v = fmaxf(v, __shfl_xor(v, o)); return v; }
DI float wave_sum(float v) { for (int o = 32; o >= 1; o >>= 1) v += __shfl_xor(v, o); return v; }
#define WAVE_SYNC() do { __builtin_amdgcn_fence(__ATOMIC_RELEASE, "wavefront"); __builtin_amdgcn_wave_barrier(); __builtin_amdgcn_fence(__ATOMIC_ACQUIRE, "wavefront"); } while (0)
DI uint4 gld16(const void* p) { uint4 r; asm volatile("global_load_dwordx4 %0, %1, off" : "=v"(r) : "v"(p) : "memory"); return r; }
DI float4 gldf4(const void* p) { float4 r; asm volatile("global_load_dwordx4 %0, %1, off" : "=v"(r) : "v"(p) : "memory"); return r; }
DI u32x4 gldv(const void* p) { u32x4 r; asm volatile("global_load_dwordx4 %0, %1, off" : "=v"(r) : "v"(p) : "memory"); return r; }
DI f32x4 gldfv(const void* p) { f32x4 r; asm volatile("global_load_dwordx4 %0, %1, off" : "=v"(r) : "v"(p) : "memory"); return r; }
DI float gld32(const void* p) { float r; asm volatile("global_load_dword %0, %1, off" : "=v"(r) : "v"(p) : "memory"); return r; }
DI void vm_wait0() { asm volatile("s_waitcnt vmcnt(0)" ::: "memory"); }
DI int crow(int i, int h) { return (i & 3) + 8 * (i >> 2) + 4 * h; }
#define MFMA16(a, b, c) __builtin_amdgcn_mfma_f32_16x16x32_bf16((a), (b), (c), 0, 0, 0)
#define MFMA32(a, b, c) __builtin_amdgcn_mfma_f32_32x32x16_bf16((a), (b), (c), 0, 0, 0)

DI int src_col(int n, int mode) {
  if (mode == 1) { int t16 = n >> 4; return (t16 & 1) * DFF + (t16 >> 1) * 16 + (n & 15); }
  if (mode == 2) {
    if (n < 1792) return n;
    if (n < 2432) return n + 8;
    if (n < 3200) return n + 20;
    if (n < 3208) return 1792 + (n - 3200);
    if (n < 3220) return 2440 + (n - 3208);
    return -1;
  }
  return n;
}
DI void conv_tile(const float* __restrict__ W, int K, int N, bf16_t* __restrict__ Wt, int mode, int tile, char* smem) {
  float* tl = (float*)smem;
  const int nK = K >> 6, kt = tile % nK, nt = tile / nK, k0 = kt * 64, n0 = nt * 64, tid = tid_();
  __syncthreads();
  { const int c = tid & 63, sc = src_col(n0 + c, mode); const int scc = sc >= 0 ? sc : 0; float wv[16];
#pragma unroll
    for (int i = 0; i < 16; ++i) wv[i] = gld32(W + (size_t)(k0 + (tid >> 6) + 4 * i) * N + scc);
    asm volatile("s_waitcnt vmcnt(0)" : "+v"(wv[0]), "+v"(wv[1]), "+v"(wv[2]), "+v"(wv[3]), "+v"(wv[4]), "+v"(wv[5]), "+v"(wv[6]), "+v"(wv[7]), "+v"(wv[8]), "+v"(wv[9]), "+v"(wv[10]), "+v"(wv[11]), "+v"(wv[12]), "+v"(wv[13]), "+v"(wv[14]), "+v"(wv[15]) :: "memory");
#pragma unroll
    for (int i = 0; i < 16; ++i) { const int r = (tid >> 6) + 4 * i; tl[r * 65 + c] = (sc >= 0) ? wv[i] : 0.f; } }
  __syncthreads();
  { const int kk2 = (tid & 31) * 2;
#pragma unroll
    for (int i = 0; i < 8; ++i) { const int nn = (tid >> 5) + 8 * i; *(unsigned*)(Wt + (size_t)(n0 + nn) * K + k0 + kk2) = pack2(tl[kk2 * 65 + nn], tl[(kk2 + 1) * 65 + nn]); } }
}
DI void convert_weights(const Params& p, int l, int which  , char* smem) {
  bf16_t* gu = (bf16_t*)(p.ws + OFF_GU); bf16_t* dn = (bf16_t*)(p.ws + OFF_DN);
  const float* sgu = (which == 1 ? p.gu1 : p.gu2) + (size_t)l * D_ * 2 * DFF;
  const float* sdn = (which == 1 ? p.dn1 : p.dn2) + (size_t)l * DFF * D_;
  const int n_gu = 16 * 88, n_dn = 44 * 16, n_in = (which == 1) ? 16 * 52 : 0, n_out = (which == 1) ? 256 : 0;
  const int total = n_gu + n_dn + n_in + n_out;
  for (int it = blockIdx.x; it < total; it += gridDim.x) {
    if (it < n_gu) conv_tile(sgu, D_, 2 * DFF, gu, 1, it, smem);
    else if (it < n_gu + n_dn) conv_tile(sdn, DFF, D_, dn, 0, it - n_gu, smem);
    else if (it < n_gu + n_dn + n_in) conv_tile(p.w_in + (size_t)l * D_ * 3220, D_, 3220, (bf16_t*)(p.ws + OFF_WIN), 2, it - n_gu - n_dn, smem);
    else conv_tile(p.w_out + (size_t)l * D_ * D_, D_, D_, (bf16_t*)(p.ws + OFF_WOUT), 0, it - n_gu - n_dn - n_in, smem);
  }
}

struct EpiArgs { bf16_t* obf; const float* resid; float* of32; float alpha, sc; const float* rope; };
DI void vm_wait8() { asm volatile("s_waitcnt vmcnt(8)" ::: "memory"); }
template <int EPI>
DI void gemm_epilogue(f32x4 (&acc)[4][4], int m0, int n0, int wm, int wn, int l15, int quad, const EpiArgs& e) {
#pragma unroll
  for (int mt = 0; mt < 4; ++mt) {
    const size_t row = (size_t)(m0 + wm * 64 + mt * 16 + l15);
    if (EPI == 0) {
#pragma unroll
      for (int q = 0; q < 2; ++q) {
        const int j = ((n0 >> 5) + wn * 2 + q) * 16 + 4 * quad; float hv[4];
#pragma unroll
        for (int i = 0; i < 4; ++i) { const float g = acc[mt][2 * q][i], u = acc[mt][2 * q + 1][i]; hv[i] = g * __builtin_amdgcn_rcpf(1.f + fexp(-g)) * u; }
        *(uint2*)(e.obf + row * DFF + j) = (uint2){pack2(hv[0], hv[1]), pack2(hv[2], hv[3])};
      }
    } else if (EPI == 1) {
      const int cb = n0 + wn * 64, spos = (int)(row & (size_t)(S_ - 1));
      const bool rd = cb < 512, rn = (cb >= C_NQ && cb < C_NKC + 64) || cb == C_NKS || cb == C_NKW;
      if (rd) {
        const f32x4 cs = *(const f32x4*)(e.rope + spos * 16 + 4 * quad), sn = *(const f32x4*)(e.rope + S_ * 16 + spos * 16 + 4 * quad);
#pragma unroll
        for (int g = 0; g < 2; ++g) { const f32x4 t1 = acc[mt][2 * g], t2 = acc[mt][2 * g + 1]; acc[mt][2 * g] = t1 * cs - t2 * sn; acc[mt][2 * g + 1] = t2 * cs + t1 * sn; }
      } else if (rn) {
#pragma unroll
        for (int g = 0; g < 2; ++g) {
          const f32x4 cs = *(const f32x4*)(e.rope + S_ * 32 + spos * 32 + g * 16 + 4 * quad), sn = *(const f32x4*)(e.rope + S_ * 64 + spos * 32 + g * 16 + 4 * quad);
          const f32x4 t1 = acc[mt][g], t2 = acc[mt][g + 2]; acc[mt][g] = t1 * cs - t2 * sn; acc[mt][g + 2] = t2 * cs + t1 * sn; }
      }
#pragma unroll
      for (int nt = 0; nt < 4; ++nt) { const int col = n0 + wn * 64 + nt * 16 + 4 * quad;
        *(uint2*)(e.obf + row * LDP + col) = (uint2){pack2(acc[mt][nt][0], acc[mt][nt][1]), pack2(acc[mt][nt][2], acc[mt][nt][3])}; }
    } else {
      float4 rv[4];
#pragma unroll
      for (int nt = 0; nt < 4; ++nt) rv[nt] = *(const float4*)(e.resid + row * D_ + n0 + wn * 64 + nt * 16 + 4 * quad);
#pragma unroll
      for (int nt = 0; nt < 4; ++nt) { const f32x4 a = acc[mt][nt];
        *(float4*)(e.of32 + row * D_ + n0 + wn * 64 + nt * 16 + 4 * quad) = (float4){e.alpha * rv[nt].x + e.sc * a[0], e.alpha * rv[nt].y + e.sc * a[1], e.alpha * rv[nt].z + e.sc * a[2], e.alpha * rv[nt].w + e.sc * a[3]}; }
    }
  }
#pragma unroll
  for (int i = 0; i < 4; ++i)
#pragma unroll
    for (int j = 0; j < 4; ++j) acc[i][j] = (f32x4){0.f, 0.f, 0.f, 0.f};
}
DI void gemm_compute(const bf16_t* sb, int wm, int wn, int l15, int quad, f32x4 (&acc)[4][4]) {
#pragma unroll
  for (int ks = 0; ks < 2; ++ks) {
    bf16x8 af[4], bfr[4];
#pragma unroll
    for (int mt = 0; mt < 4; ++mt) af[mt] = *(const bf16x8*)(sb + ((ks * 4 + quad) * 128 + wm * 64 + mt * 16 + (l15 & 8) + ((l15 + ks * 4 + quad) & 7)) * 8);
#pragma unroll
    for (int nt = 0; nt < 4; ++nt) bfr[nt] = *(const bf16x8*)(sb + 8192 + ((ks * 4 + quad) * 128 + wn * 64 + nt * 16 + (l15 & 8) + ((l15 + ks * 4 + quad) & 7)) * 8);
#pragma unroll
    for (int mt = 0; mt < 4; ++mt)
#pragma unroll
      for (int nt = 0; nt < 4; ++nt) acc[mt][nt] = MFMA16(af[mt], bfr[nt], acc[mt][nt]);
  }
}
DI void gemm_compute_sw(const bf16_t* sb, int wm, int wn, int l15, int quad, f32x4 (&acc)[4][4]) {
#pragma unroll
  for (int ks = 0; ks < 2; ++ks) {
    bf16x8 af[4], bfr[4];
    const int sl = ((ks * 4 + quad) ^ ((l15 >> 1) & 7)) * 8;
#pragma unroll
    for (int mt = 0; mt < 4; ++mt) af[mt] = *(const bf16x8*)(sb + (wm * 64 + mt * 16 + l15) * 64 + sl);
#pragma unroll
    for (int nt = 0; nt < 4; ++nt) bfr[nt] = *(const bf16x8*)(sb + 8192 + (wn * 64 + nt * 16 + l15) * 64 + sl);
#pragma unroll
    for (int mt = 0; mt < 4; ++mt)
#pragma unroll
      for (int nt = 0; nt < 4; ++nt) acc[mt][nt] = MFMA16(bfr[nt], af[mt], acc[mt][nt]);
  }
}
template <int EPI>
DI void gemm_phase(const bf16_t* __restrict__ A, int lda, const bf16_t* __restrict__ Bt, int K, int N, char* smem, const EpiArgs& e) {
  const int NT = N >> 7, ntiles = 128 * NT, nk = K >> 6;
  if ((int)blockIdx.x >= ntiles) return;
  const int cnt = (ntiles - (int)blockIdx.x + (int)gridDim.x - 1) / (int)gridDim.x, total = cnt * nk;
  const int tid = tid_(), lane = tid & 63, wave = __builtin_amdgcn_readfirstlane(tid >> 6), wm = wave >> 1, wn = wave & 1, l15 = lane & 15, quad = lane >> 4;
  bf16_t* sm = (bf16_t*)smem;
  const int lr = wave * 8 + (lane >> 3), lch = (lane & 7) ^ ((lr >> 1) & 7);
#define TILE_MN(tile_, m0_, n0_) { const int x_ = (tile_) & 7, u_ = (tile_) >> 3; m0_ = (x_ * 16 + (u_ & 15)) * 128; n0_ = (u_ >> 4) * 128; }
  int ltile = blockIdx.x, lk = 0, lg = 0; const bf16_t *Ag, *Bg;
  { int m0, n0; TILE_MN(ltile, m0, n0); Ag = A + (size_t)(m0 + lr) * lda + lch * 8; Bg = Bt + (size_t)(n0 + lr) * K + lch * 8; }
#define G_ISSUE(buf_) { bf16_t* sw = sm + (buf_) * 16384 + wave * 512; \
    _Pragma("unroll") for (int q = 0; q < 4; ++q) { \
      __builtin_amdgcn_global_load_lds((const unsigned*)(Ag + (size_t)(32 * q) * lda + lk * 64), (unsigned*)(sw + q * 2048), 16, 0, 0); \
      __builtin_amdgcn_global_load_lds((const unsigned*)(Bg + (size_t)(32 * q) * K + lk * 64), (unsigned*)(sw + 8192 + q * 2048), 16, 0, 0); } \
    if (lg + 1 < total) { ++lg; if (++lk == nk) { lk = 0; ltile += gridDim.x; int m0, n0; TILE_MN(ltile, m0, n0); Ag = A + (size_t)(m0 + lr) * lda + lch * 8; Bg = Bt + (size_t)(n0 + lr) * K + lch * 8; } } }
  f32x4 acc[4][4];
#pragma unroll
  for (int i = 0; i < 4; ++i)
#pragma unroll
    for (int j = 0; j < 4; ++j) acc[i][j] = (f32x4){0.f, 0.f, 0.f, 0.f};
  __syncthreads();
  G_ISSUE(0);
  vm_wait0();
  __syncthreads();
  int ctile = blockIdx.x, ck = 0;
  for (int g = 0; g < total; g += 2) {
    G_ISSUE(1);
    gemm_compute_sw(sm, wm, wn, l15, quad, acc);
    vm_wait0();
    __syncthreads();
    G_ISSUE(0);
    gemm_compute_sw(sm + 16384, wm, wn, l15, quad, acc);
    vm_wait0();
    __syncthreads();
    ck += 2;
    if (ck == nk) { int m0, n0; TILE_MN(ctile, m0, n0); gemm_epilogue<EPI>(acc, m0, n0, wm, wn, l15, quad, e); ck = 0; ctile += gridDim.x; }
  }
#undef G_ISSUE
#undef TILE_MN
}

DI void ln_phase(float* x32, bf16_t* xb, const float* g, const float* b) {
  const int lane = tid_() & 63, wv = tid_() >> 6;
  float4 gg[4], bb[4];
#pragma unroll
  for (int j = 0; j < 4; ++j) { gg[j] = *(const float4*)(g + j * 256 + lane * 4); bb[j] = *(const float4*)(b + j * 256 + lane * 4); }
  for (int row = blockIdx.x * 4 + wv; row < T_; row += gridDim.x * 4) {
    f32x4 v[4];
#pragma unroll
    for (int j = 0; j < 4; ++j) v[j] = gldfv(x32 + (size_t)row * D_ + j * 256 + lane * 4);
    asm volatile("s_waitcnt vmcnt(0)" : "+v"(v[0]), "+v"(v[1]), "+v"(v[2]), "+v"(v[3]) :: "memory");
    float s = 0.f;
#pragma unroll
    for (int j = 0; j < 4; ++j) s += (v[j][0] + v[j][1]) + (v[j][2] + v[j][3]);
    s = wave_sum(s); const float mu = s * (1.f / D_); float q = 0.f;
#pragma unroll
    for (int j = 0; j < 4; ++j) { v[j] -= mu; q += v[j][0] * v[j][0] + v[j][1] * v[j][1] + v[j][2] * v[j][2] + v[j][3] * v[j][3]; }
    q = wave_sum(q); const float rs = rsqrtf(q * (1.f / D_) + 1e-5f);
#pragma unroll
    for (int j = 0; j < 4; ++j) {
      const int c = j * 256 + lane * 4;
      float4 y; y.x = v[j][0] * rs * gg[j].x + bb[j].x; y.y = v[j][1] * rs * gg[j].y + bb[j].y; y.z = v[j][2] * rs * gg[j].z + bb[j].z; y.w = v[j][3] * rs * gg[j].w + bb[j].w;
      *(float4*)(x32 + (size_t)row * D_ + c) = y;
      uint2 pk; pk.x = pack2(y.x, y.y); pk.y = pack2(y.z, y.w); *(uint2*)(xb + (size_t)row * D_ + c) = pk;
    }
  }
}

DI void sincos_d(double r, double& sn, double& cs) {
  const double r2 = r * r; double a = 1.0, c = 1.0;
#pragma unroll
  for (int k = 14; k >= 1; --k) { a = 1.0 - r2 / (double)((2 * k) * (2 * k + 1)) * a; c = 1.0 - r2 / (double)((2 * k - 1) * (2 * k)) * c; }
  sn = r * a; cs = c;
}
DI void prologue_phase(const Params& p) {
  const size_t gt = (size_t)blockIdx.x * 256 + tid_(), gs = (size_t)gridDim.x * 256;
  float* rope = (float*)(p.ws + OFF_ROPE);
  for (size_t idx = gt; idx < (size_t)S_ * 48; idx += gs) {
    const int s = (int)(idx / 48), i = (int)(idx % 48); const int dim = i < 16 ? 32 : 64, fi = i < 16 ? i : i - 16;
    const float inv = powf(10000.f, -((float)(2 * fi) / (float)dim));
    const float ang = (float)s * inv;
    const double a = (double)ang, n = rint(a * 0.15915494309189535), r = a - n * 6.283185307179586;
    double sn, cs; sincos_d(r, sn, cs);
    if (i < 16) { rope[s * 16 + fi] = (float)cs; rope[S_ * 16 + s * 16 + fi] = (float)sn; }
    else { rope[S_ * 32 + s * 32 + fi] = (float)cs; rope[S_ * 64 + s * 32 + fi] = (float)sn; }
  }
  bf16_t* xb = (bf16_t*)(p.ws + OFF_XB);
  for (size_t i4 = gt; i4 < (size_t)T_ * D_ / 4; i4 += gs) {
    const float4 v = ((const float4*)p.x)[i4]; uint2 pk; pk.x = pack2(v.x, v.y); pk.y = pack2(v.z, v.w); ((uint2*)xb)[i4] = pk;
  }
}

DI void rope_phase(const Params& p) {
  bf16_t* proj = (bf16_t*)(p.ws + OFF_BIG); const float* rope = (const float*)(p.ws + OFF_ROPE);
  const size_t gt = (size_t)blockIdx.x * 256 + tid_(), gs = (size_t)gridDim.x * 256;
  for (size_t idx = gt; idx < (size_t)T_ * 60; idx += gs) {
    const int tok = (int)(idx / 60), u = (int)(idx % 60), s = tok & (S_ - 1);
    int c1, half; const float *cp, *sp;
    if (u < 32) { const int g = u >> 1, i0 = (u & 1) * 8; c1 = g * 32 + i0; half = 16; cp = rope + s * 16 + i0; sp = rope + S_ * 16 + s * 16 + i0; }
    else { const int q = u - 32, g = q >> 2, i0 = (q & 3) * 8;
      const int base = g < 4 ? C_NQ + g * 64 : (g == 4 ? C_NKC : (g == 5 ? C_NKS : C_NKW));
      c1 = base + i0; half = 32; cp = rope + S_ * 32 + s * 32 + i0; sp = rope + S_ * 64 + s * 32 + i0; }
    bf16_t* row = proj + (size_t)tok * LDP + c1;
    u32x4 a = gldv(row), bq = gldv(row + half); f32x4 c0 = gldfv(cp), c4 = gldfv(cp + 4), s0 = gldfv(sp), s4 = gldfv(sp + 4);
    asm volatile("s_waitcnt vmcnt(0)" : "+v"(a), "+v"(bq), "+v"(c0), "+v"(c4), "+v"(s0), "+v"(s4) :: "memory");
    u32x4 oa, ob;
#pragma unroll
    for (int w = 0; w < 4; ++w) {
      const float t1a = __uint_as_float(a[w] << 16), t1b = __uint_as_float(a[w] & 0xffff0000u), t2a = __uint_as_float(bq[w] << 16), t2b = __uint_as_float(bq[w] & 0xffff0000u);
      const float ca = w < 2 ? c0[2 * w] : c4[2 * w - 4], cb = w < 2 ? c0[2 * w + 1] : c4[2 * w - 3], sa = w < 2 ? s0[2 * w] : s4[2 * w - 4], sb = w < 2 ? s0[2 * w + 1] : s4[2 * w - 3];
      oa[w] = pack2(t1a * ca - t2a * sa, t1b * cb - t2b * sb); ob[w] = pack2(t2a * ca + t1a * sa, t2b * cb + t1b * sb);
    }
    *(u32x4*)row = oa; *(u32x4*)(row + half) = ob;
  }
}
DI void vt_tile(const Params& p, int item, char* smem) {
  const bf16_t* proj = (const bf16_t*)(p.ws + OFF_BIG); bf16_t* vt = (bf16_t*)(p.ws + OFF_VT);
  const int slot = item >> 8, t0 = (item & 255) * 64, tid = tid_();
  const int col = slot < 4 ? C_DV + slot * 64 : (slot < 8 ? C_SV + (slot - 4) * 64 : (slot == 8 ? C_NVW : C_NVS));
  bf16_t* tl = (bf16_t*)smem;
  __syncthreads();
#pragma unroll
  for (int i = 0; i < 2; ++i) { const int idx = tid + 256 * i, tk = idx >> 3, c = idx & 7;
    const uint4 v = *(const uint4*)(proj + (size_t)(t0 + tk) * LDP + col + c * 8);
    unsigned* d = (unsigned*)(tl + tk * 66 + c * 8); d[0] = v.x; d[1] = v.y; d[2] = v.z; d[3] = v.w; }
  __syncthreads();
#pragma unroll
  for (int i = 0; i < 8; ++i) { const int idx = tid + 256 * i, dv = idx >> 5, t2 = (idx & 31) * 2;
    const unsigned v = (unsigned)tl[t2 * 66 + dv] | ((unsigned)tl[(t2 + 1) * 66 + dv] << 16);
    *(unsigned*)(vt + (size_t)(slot * 64 + dv) * VLD + t0 + t2) = v; }
}
DI void gdn_conv(const Params& p, int l, int b, int hh, int s0, int which, float* dst, int ld, bool norm, float scale) {
  const bf16_t* proj = (const bf16_t*)(p.ws + OFF_BIG);
  const int tid = tid_(), c = tid >> 2, part = tid & 3;
  const int colbase = (which == 0 ? C_GQ : (which == 1 ? C_GK : C_GV)) + hh * 64 + part * 16, wch = which * 256 + hh * 64 + part * 16;
  u32x4 xv[8]; f32x4 wv[16];
#pragma unroll
  for (int j = 0; j < 4; ++j) {
    int sj = s0 + c - 3 + j; if (sj < 0) sj = 0;
    const bf16_t* xr = proj + (size_t)(b * S_ + sj) * LDP + colbase;
    xv[2 * j] = gldv(xr); xv[2 * j + 1] = gldv(xr + 8);
    const float* wr = p.convw + (size_t)(l * 4 + j) * 768 + wch;
#pragma unroll
    for (int q = 0; q < 4; ++q) wv[4 * j + q] = gldfv(wr + 4 * q);
  }
  asm volatile("s_waitcnt vmcnt(0)" : "+v"(xv[0]), "+v"(xv[1]), "+v"(xv[2]), "+v"(xv[3]), "+v"(xv[4]), "+v"(xv[5]), "+v"(xv[6]), "+v"(xv[7]),
               "+v"(wv[0]), "+v"(wv[1]), "+v"(wv[2]), "+v"(wv[3]), "+v"(wv[4]), "+v"(wv[5]), "+v"(wv[6]), "+v"(wv[7]),
               "+v"(wv[8]), "+v"(wv[9]), "+v"(wv[10]), "+v"(wv[11]), "+v"(wv[12]), "+v"(wv[13]), "+v"(wv[14]), "+v"(wv[15]) :: "memory");
  float acc[16];
#pragma unroll
  for (int d = 0; d < 16; ++d) acc[d] = 0.f;
#pragma unroll
  for (int j = 0; j < 4; ++j) {
    const float msk = (s0 + c - 3 + j >= 0) ? 1.f : 0.f;
#pragma unroll
    for (int q = 0; q < 4; ++q) {
      const unsigned x0 = xv[2 * j + (q >> 1)][(q & 1) * 2], x1 = xv[2 * j + (q >> 1)][(q & 1) * 2 + 1]; const f32x4 w = wv[4 * j + q];
      acc[4 * q] += msk * w[0] * __uint_as_float(x0 << 16); acc[4 * q + 1] += msk * w[1] * __uint_as_float(x0 & 0xffff0000u);
      acc[4 * q + 2] += msk * w[2] * __uint_as_float(x1 << 16); acc[4 * q + 3] += msk * w[3] * __uint_as_float(x1 & 0xffff0000u);
    }
  }
  float ss = 0.f;
#pragma unroll
  for (int d = 0; d < 16; ++d) { acc[d] = acc[d] / (1.f + __expf(-acc[d])); ss += acc[d] * acc[d]; }
  if (norm) { ss += __shfl_xor(ss, 1); ss += __shfl_xor(ss, 2); const float rn = rsqrtf(ss + 1e-6f) * scale;
#pragma unroll
    for (int d = 0; d < 16; ++d) acc[d] *= rn; }
#pragma unroll
  for (int d = 0; d < 16; ++d) dst[c * ld + part * 16 + d] = acc[d];
}
DI float softplus_f(float x) { return x > 20.f ? x : log1pf(expf(x)); }
DI void gdn_gates(const Params& p, int l, int b, int hh, int s0, float* sG, float* sBeta) {
  const bf16_t* proj = (const bf16_t*)(p.ws + OFF_BIG); const int tid = tid_();
  if (tid < 64) { const bf16_t* row = proj + (size_t)(b * S_ + s0 + tid) * LDP;
    const float a = bf2f(row[C_GA + hh]), bb = bf2f(row[C_GB + hh]);
    sG[tid] = -expf(p.alog[l * 4 + hh]) * softplus_f(a + p.dtb[l * 4 + hh]); sBeta[tid] = 1.f / (1.f + expf(-bb)); }
  __syncthreads();
  if (tid < 64) { float v = sG[tid];
#pragma unroll
    for (int o = 1; o < 64; o <<= 1) { const float u = __shfl_up(v, o); if (tid >= o) v += u; }
    sG[tid] = v; }
  __syncthreads();
}
DI void gdn_g1(const Params& p, int l, int ch, char* smem) {
  const int b = ch >> 9, hh = (ch >> 7) & 3, n = ch & 127, s0 = n * 64, tid = tid_(), c = tid >> 2, part = tid & 3;
  float* sA = (float*)smem; float* sR = sA + 4096; float* sG = sR + 64 * 129; float* sBeta = sG + 64;
  float* U = (float*)(p.ws + OFF_GU_) + (size_t)ch * 4096; float* W = (float*)(p.ws + OFF_GW) + (size_t)ch * 4096; float* KD = (float*)(p.ws + OFF_GKD) + (size_t)ch * 4096;
  __syncthreads();
  gdn_gates(p, l, b, hh, s0, sG, sBeta);
  gdn_conv(p, l, b, hh, s0, 1, sR + 64, 129, true, 1.f);
  gdn_conv(p, l, b, hh, s0, 2, sR, 129, false, 1.f);
  __syncthreads();
  const float Glast = sG[63], Gc = sG[c], bc = sBeta[c];
  { const float f = expf(Glast - Gc);
#pragma unroll
    for (int d = 0; d < 16; ++d) KD[c * 64 + part * 16 + d] = sR[c * 129 + 64 + part * 16 + d] * f; }
  for (int i = 0; i < 16; ++i) { const int s = part + 4 * i; float a = 0.f;
    if (s < c) { float dot = 0.f;
#pragma unroll 16
      for (int d = 0; d < 64; ++d) dot += sR[c * 129 + 64 + d] * sR[s * 129 + 64 + d];
      a = bc * dot * expf(Gc - sG[s]); }
    sA[c * 64 + s] = a; }
  __syncthreads();
  { const float f2 = bc * expf(Gc);
#pragma unroll
    for (int d = 0; d < 16; ++d) { sR[c * 129 + part * 16 + d] *= bc; sR[c * 129 + 64 + part * 16 + d] *= f2; } }
  __syncthreads();
  if (tid < 128) {
    float sol[64];
#pragma unroll
    for (int cc = 0; cc < 64; ++cc) sol[cc] = sR[cc * 129 + tid];
#pragma unroll
    for (int cc = 1; cc < 64; ++cc) { float a0 = 0.f, a1 = 0.f;
#pragma unroll
      for (int s2 = 0; s2 < cc; ++s2) { if (s2 & 1) a1 += sA[cc * 64 + s2] * sol[s2]; else a0 += sA[cc * 64 + s2] * sol[s2]; }
      sol[cc] -= a0 + a1; }
#pragma unroll
    for (int cc = 1; cc < 64; ++cc) sR[cc * 129 + tid] = sol[cc];
  }
  __syncthreads();
#pragma unroll
  for (int d = 0; d < 16; ++d) { U[c * 64 + part * 16 + d] = sR[c * 129 + part * 16 + d]; W[c * 64 + part * 16 + d] = sR[c * 129 + 64 + part * 16 + d]; }
  if (tid == 0) ((float*)(p.ws + OFF_GLAST))[ch] = expf(Glast);
}
DI void m0_phase(const Params& p, int l, char* smem) {
  if (blockIdx.x == 0 && tid_() < 64) ((unsigned*)(p.ws + OFF_CNT))[tid_()] = 0u;
  for (int it = blockIdx.x; it < 2560 + 1024; it += gridDim.x) {
    if (it < 1024) gdn_g1(p, l, it, smem); else vt_tile(p, it - 1024, smem);
  }
}

struct KVRegs { u32x4 k[2], v[2]; };
DI void kv_wait(KVRegs& rg) { asm volatile("s_waitcnt vmcnt(0)" : "+v"(rg.k[0]), "+v"(rg.k[1]), "+v"(rg.v[0]), "+v"(rg.v[1]) :: "memory"); }
template <int DQK> DI void kv_issue(const bf16_t* Kb, const bf16_t* Vt, int k0, KVRegs& rg) {
  const int tid = tid_();
  if (DQK == 64) {
#pragma unroll
    for (int q = 0; q < 2; ++q) { const int idx = tid + 256 * q, key = idx >> 3, c = idx & 7; rg.k[q] = gldv(Kb + (size_t)(k0 + key) * LDP + c * 8); }
  } else { const int key = tid >> 2, c = tid & 3; rg.k[0] = gldv(Kb + (size_t)(k0 + key) * LDP + c * 8); }
#pragma unroll
  for (int q = 0; q < 2; ++q) { const int idx = tid + 256 * q, dv = idx >> 3, c = idx & 7; rg.v[q] = gldv(Vt + (size_t)dv * VLD + k0 + c * 8); }
}
template <int DQK> DI void kv_commit(const KVRegs& rg, bf16_t* sK, bf16_t* sV) {
  constexpr int LDK = DQK + 8; const int tid = tid_();
  if (DQK == 64) {
#pragma unroll
    for (int q = 0; q < 2; ++q) { const int idx = tid + 256 * q, key = idx >> 3, c = idx & 7; *(u32x4*)(sK + key * LDK + c * 8) = rg.k[q]; }
  } else { const int key = tid >> 2, c = tid & 3; *(u32x4*)(sK + key * LDK + c * 8) = rg.k[0]; }
#pragma unroll
  for (int q = 0; q < 2; ++q) { const int idx = tid + 256 * q, dv = idx >> 3, c = idx & 7; const u32x4 v = rg.v[q];
    uint2* d = (uint2*)(sV + dv * 68 + c * 8); d[0] = (uint2){v[0], v[1]}; d[1] = (uint2){v[2], v[3]}; }
}
DI bf16x8 pack8(const f32x16& x, int s) {
  bf16x8 r;
#pragma unroll
  for (int j = 0; j < 8; ++j) r[j] = (short)f2bf(x[8 * s + j]);
  return r;
}
DI void pv_accum(const f32x16 (&s)[2], const bf16_t* sV, int r, int h, f32x16 (&O)[2]) {
#pragma unroll
  for (int t2 = 0; t2 < 2; ++t2)
#pragma unroll
    for (int s2 = 0; s2 < 2; ++s2) {
      const bf16x8 pf = pack8(s[t2], s2);
#pragma unroll
      for (int dt = 0; dt < 2; ++dt) {
        const bf16_t* vp = sV + (dt * 32 + r) * 68 + t2 * 32 + 16 * s2 + 4 * h;
        const s16x4 lo = *(const s16x4*)vp, hi = *(const s16x4*)(vp + 8);
        const bf16x8 vf = __builtin_shufflevector(lo, hi, 0, 1, 2, 3, 4, 5, 6, 7);
        O[dt] = MFMA32(vf, pf, O[dt]);
      }
    }
}
template <int DQK>
DI void attn_tile_step(const bf16_t* sK, const bf16_t* sV, const bf16x8 (&qf)[DQK / 16], int k0, int qpos, int window, float sl2, float& m, float& lsum, f32x16 (&O)[2], int r, int h) {
  constexpr int NKS = DQK / 16, LDK = DQK + 8;
  f32x16 s[2];
#pragma unroll
  for (int t2 = 0; t2 < 2; ++t2) {
#pragma unroll
    for (int i = 0; i < 16; ++i) s[t2][i] = 0.f;
#pragma unroll
    for (int ks = 0; ks < NKS; ++ks) { const bf16x8 a = *(const bf16x8*)(sK + (t2 * 32 + r) * LDK + ks * 16 + 8 * h); s[t2] = MFMA32(a, qf[ks], s[t2]); }
  }
  float mx = m;
#pragma unroll
  for (int t2 = 0; t2 < 2; ++t2)
#pragma unroll
    for (int i = 0; i < 16; ++i) { const int kpos = k0 + t2 * 32 + crow(i, h); const bool ok = (kpos <= qpos) && (window == 0 || qpos - kpos < window);
      const float v = ok ? s[t2][i] * sl2 : -1e30f; s[t2][i] = v; mx = fmaxf(mx, v); }
  mx = fmaxf(mx, __shfl_xor(mx, 32));
  const float corr = fexp2(m - mx); m = mx; float ps = 0.f;
#pragma unroll
  for (int t2 = 0; t2 < 2; ++t2)
#pragma unroll
    for (int i = 0; i < 16; ++i) { const float pv = (s[t2][i] > -1e29f) ? fexp2(s[t2][i] - mx) : 0.f; s[t2][i] = pv; ps += pv; }
  lsum = lsum * corr + ps;
#pragma unroll
  for (int dt = 0; dt < 2; ++dt)
#pragma unroll
    for (int i = 0; i < 16; ++i) O[dt][i] *= corr;
  pv_accum(s, sV, r, h, O);
}
DI void o_zero(f32x16 (&O)[2]) {
#pragma unroll
  for (int dt = 0; dt < 2; ++dt)
#pragma unroll
    for (int i = 0; i < 16; ++i) O[dt][i] = 0.f;
}
DI void o_finish(f32x16 (&O)[2], float lsum) {
  lsum += __shfl_xor(lsum, 32);
  const float inv = 1.f / lsum;
#pragma unroll
  for (int dt = 0; dt < 2; ++dt)
#pragma unroll
    for (int i = 0; i < 16; ++i) O[dt][i] *= inv;
}
DI void store_o(const f32x16 (&O)[2], bf16_t* dst  , int h) {
#pragma unroll
  for (int dt = 0; dt < 2; ++dt)
#pragma unroll
    for (int g = 0; g < 4; ++g) { uint2 pk; pk.x = pack2(O[dt][4 * g], O[dt][4 * g + 1]); pk.y = pack2(O[dt][4 * g + 2], O[dt][4 * g + 3]); *(uint2*)(dst + dt * 32 + 8 * g + 4 * h) = pk; }
}
DI void diff_item(const Params& p, int l, int b, int hh, int qb, char* smem) {
  const bf16_t* proj = (const bf16_t*)(p.ws + OFF_BIG) + (size_t)(b * S_) * LDP;
  const bf16_t* vt = (const bf16_t*)(p.ws + OFF_VT) + (size_t)(hh * 64) * VLD + b * S_;
  const int q0 = qb * 128, tid = tid_(), lane = tid & 63, wave = tid >> 6, r = lane & 31, h = lane >> 5, qw0 = q0 + wave * 32, qpos = qw0 + r;
  bf16_t* sK1 = (bf16_t*)smem; bf16_t* sK2 = sK1 + 64 * 40; bf16_t* sV = sK2 + 64 * 40;
  float d1 = 0.f, d2 = 0.f;
  for (int i = 0; i < 32; ++i) { d1 += p.lq1[l * 32 + i] * p.lk1[l * 32 + i]; d2 += p.lq2[l * 32 + i] * p.lk2[l * 32 + i]; }
  asm volatile("" : "+v"(d1), "+v"(d2));
  const float lam_init = 0.8f - 0.6f * expf(-0.3f * (float)l), lam = expf(d1) - expf(d2) + lam_init;
  const float sl2 = 0.17677669529663687f * 1.4426950408889634f;
  bf16x8 qf1[2], qf2[2];
#pragma unroll
  for (int ks = 0; ks < 2; ++ks) { qf1[ks] = *(const bf16x8*)(proj + (size_t)qpos * LDP + C_DQ1 + hh * 32 + ks * 16 + 8 * h); qf2[ks] = *(const bf16x8*)(proj + (size_t)qpos * LDP + C_DQ2 + hh * 32 + ks * 16 + 8 * h); }
  f32x16 O1[2], O2[2]; o_zero(O1); o_zero(O2);
  float m1 = -1e30f, m2 = -1e30f, l1 = 0.f, l2 = 0.f;
  const int kt1 = (q0 + 128) >> 6;
  const bf16_t* K1g = proj + C_DK1 + hh * 32; const bf16_t* K2g = proj + C_DK2 + hh * 32;
  KVRegs rg; rg.k[1] = (u32x4){0u, 0u, 0u, 0u}; uint4 rk2;
  kv_issue<32>(K1g, vt, 0, rg); rk2 = gld16(K2g + (size_t)(tid >> 2) * LDP + (tid & 3) * 8);
  kv_wait(rg); vm_wait0();
  __syncthreads();
  kv_commit<32>(rg, sK1, sV); *(uint4*)(sK2 + (tid >> 2) * 40 + (tid & 3) * 8) = rk2;
  __syncthreads();
  { const int kn = (1 < kt1 ? 1 : 0) * 64; kv_issue<32>(K1g, vt, kn, rg); rk2 = gld16(K2g + (size_t)(kn + (tid >> 2)) * LDP + (tid & 3) * 8); }
#pragma unroll 1
  for (int kt = 0; kt < kt1; ++kt) {
    const int k0 = kt * 64, bo = (kt & 1) * 9728, bn = ((kt + 1) & 1) * 9728;
    if (k0 <= qw0 + 31) {
      attn_tile_step<32>(sK1 + bo, sV + bo, qf1, k0, qpos, 0, sl2, m1, l1, O1, r, h);
      __builtin_amdgcn_sched_barrier(0);
      attn_tile_step<32>(sK2 + bo, sV + bo, qf2, k0, qpos, 0, sl2, m2, l2, O2, r, h);
      __builtin_amdgcn_sched_barrier(0);
    }
    kv_wait(rg); vm_wait0();
    kv_commit<32>(rg, sK1 + bn, sV + bn); *(uint4*)(sK2 + bn + (tid >> 2) * 40 + (tid & 3) * 8) = rk2;
    __syncthreads();
    { const int kn = (kt + 2 < kt1 ? kt + 2 : kt1 - 1) * 64; kv_issue<32>(K1g, vt, kn, rg); rk2 = gld16(K2g + (size_t)(kn + (tid >> 2)) * LDP + (tid & 3) * 8); }
  }
  vm_wait0();
  o_finish(O1, l1); o_finish(O2, l2);
  float ss = 0.f;
#pragma unroll
  for (int dt = 0; dt < 2; ++dt)
#pragma unroll
    for (int i = 0; i < 16; ++i) { const float o = O1[dt][i] - lam * O2[dt][i]; O1[dt][i] = o; ss += o * o; }
  ss += __shfl_xor(ss, 32);
  const float rn = rsqrtf(ss * (1.f / 64.f) + 1e-6f) * (1.f - lam_init);
  int goff = l * 64 + 4 * h; asm volatile("" : "+v"(goff));
#pragma unroll
  for (int dt = 0; dt < 2; ++dt)
#pragma unroll
    for (int g = 0; g < 4; ++g) { const float4 gg = *(const float4*)(p.subln + goff + dt * 32 + 8 * g);
      O1[dt][4 * g] *= rn * gg.x; O1[dt][4 * g + 1] *= rn * gg.y; O1[dt][4 * g + 2] *= rn * gg.z; O1[dt][4 * g + 3] *= rn * gg.w; }
  bf16_t* mix = (bf16_t*)(p.ws + OFF_XB);
  store_o(O1, mix + (size_t)(b * S_ + qpos) * D_ + hh * 64, h);
}
DI void win_item(const Params& p, int b, int hh, int qb, char* smem) {
  const bf16_t* proj = (const bf16_t*)(p.ws + OFF_BIG) + (size_t)(b * S_) * LDP;
  const bf16_t* vt = (const bf16_t*)(p.ws + OFF_VT) + (size_t)(8 * 64) * VLD + b * S_;
  const int q0 = qb * 128, lane = tid_() & 63, wave = tid_() >> 6, r = lane & 31, h = lane >> 5, qw0 = q0 + wave * 32, qpos = qw0 + r;
  bf16_t* sK = (bf16_t*)smem; bf16_t* sV = sK + 64 * 72;
  int kt0 = (q0 >> 6) - 8; if (kt0 < 0) kt0 = 0;
  bf16x8 qf[4];
#pragma unroll
  for (int ks = 0; ks < 4; ++ks) qf[ks] = *(const bf16x8*)(proj + (size_t)qpos * LDP + C_NQ + hh * 64 + ks * 16 + 8 * h);
  f32x16 O[2]; o_zero(O);
  float m = -1e30f, lsum = 0.f;
  const int kt1 = (q0 + 128) >> 6;
  KVRegs rg; kv_issue<64>(proj + C_NKW, vt, kt0 * 64, rg);
#pragma unroll 1
  for (int kt = kt0; kt < kt1; ++kt) {
    const int k0 = kt * 64;
    kv_wait(rg);
    __syncthreads();
    kv_commit<64>(rg, sK, sV);
    __syncthreads();
    kv_issue<64>(proj + C_NKW, vt, (kt + 1 < kt1 ? kt + 1 : kt) * 64, rg);
    if (k0 > qw0 + 31) continue;
    if (k0 + 63 < qw0 - 511) continue;
    attn_tile_step<64>(sK, sV, qf, k0, qpos, 512, 0.125f * 1.4426950408889634f, m, lsum, O, r, h);
  }
  vm_wait0();
  o_finish(O, lsum);
  bf16_t* ow = (bf16_t*)(p.ws + OFF_OWIN);
  store_o(O, ow + (size_t)(b * S_ + qpos) * 256 + hh * 64, h);
}
DI void sb_item(const Params& p, int b, int hh, int qb, char* smem) {
  const bf16_t* proj = (const bf16_t*)(p.ws + OFF_BIG) + (size_t)(b * S_) * LDP;
  const bf16_t* Qb = proj + C_SQ + hh * 64; const bf16_t* Kb = proj + C_SK + hh * 64;
  const bf16_t* Vt = (const bf16_t*)(p.ws + OFF_VT) + (size_t)((4 + hh) * 64) * VLD + b * S_;
  bf16_t* sK = (bf16_t*)smem; bf16_t* sV = sK + 64 * 72;
  const int q0 = qb * 128, lane = tid_() & 63, wave = tid_() >> 6, r = lane & 31, h = lane >> 5;
  const int qw0 = q0 + wave * 32, qpos = qw0 + r;
  bf16x8 qf[4];
#pragma unroll
  for (int ks = 0; ks < 4; ++ks) qf[ks] = *(const bf16x8*)(Qb + (size_t)qpos * LDP + ks * 16 + 8 * h);
  f32x16 O[2];
#pragma unroll
  for (int dt = 0; dt < 2; ++dt)
#pragma unroll
    for (int i = 0; i < 16; ++i) O[dt][i] = 0.f;
  float R = 0.f;
  float* sflag = (float*)(smem + 20480);
  if (tid_() < 4) sflag[tid_()] = 0.f;
  KVRegs rg; kv_issue<64>(Kb, Vt, ((q0 + 127) >> 6) * 64, rg);
#pragma unroll 1
  for (int kt = (q0 + 127) >> 6; kt >= 0; --kt) {
    const int k0 = kt * 64;
    kv_wait(rg);
    __syncthreads();
    const float rmin = fminf(fminf(sflag[0], sflag[1]), fminf(sflag[2], sflag[3]));
    if (rmin > 90.f) break;
    kv_commit<64>(rg, sK, sV);
    __syncthreads();
    kv_issue<64>(Kb, Vt, (kt > 0 ? kt - 1 : 0) * 64, rg);
    if (k0 >= qw0 + 31) continue;
    { const float wmin = -wave_max(-R); if (wmin > 90.f) continue; }
    f32x16 s[2];
#pragma unroll
    for (int t2 = 0; t2 < 2; ++t2) {
#pragma unroll
      for (int i = 0; i < 16; ++i) s[t2][i] = 0.f;
#pragma unroll
      for (int ks = 0; ks < 4; ++ks) { const bf16x8 a = *(const bf16x8*)(sK + (t2 * 32 + r) * 72 + ks * 16 + 8 * h); s[t2] = MFMA32(a, qf[ks], s[t2]); }
    }
    float Tt = 0.f;
#pragma unroll
    for (int t2 = 1; t2 >= 0; --t2)
#pragma unroll
      for (int g = 3; g >= 0; --g) {
        float z[4], sp[4]; bool ok[4]; float gs = 0.f;
#pragma unroll
        for (int e = 0; e < 4; ++e) { const int kpos = k0 + t2 * 32 + 8 * g + 4 * h + e; ok[e] = kpos < qpos; z[e] = s[t2][4 * g + e] * 0.125f;
          const float spv = fmaxf(z[e], 0.f) + flog(1.f + fexp(-fabsf(z[e]))); sp[e] = ok[e] ? spv : 0.f; gs += sp[e]; }
        const float pg = __shfl_xor(gs, 32);
        float run = R + Tt + (h == 0 ? pg : 0.f);
#pragma unroll
        for (int e = 3; e >= 0; --e) { run += sp[e]; s[t2][4 * g + e] = ok[e] ? fexp(z[e] - run) : 0.f; }
        Tt += gs + pg;
      }
    R += Tt;
    { const float wmin = -wave_max(-R); if (lane == 0) sflag[wave] = wmin; }
    pv_accum(s, sV, r, h, O);
  }
  vm_wait0();
  bf16_t* mix = (bf16_t*)(p.ws + OFF_XB);
  store_o(O, mix + (size_t)(b * S_ + qpos) * D_ + 768 + hh * 64, h);
}

DI void gdn_chain(const Params& p, int item, char* smem) {
  const int b = item >> 4, hh = (item >> 2) & 3, sl = item & 3, tid = tid_(), c = tid >> 2, e4 = (tid & 3) * 4;
  float* sW = (float*)smem; float* sKD = sW + 64 * 65; float* sS = sKD + 64 * 65; float* sV = sS + 1024; float* sU = sV + 1024;
  float* U = (float*)(p.ws + OFF_GU_); const float* W = (const float*)(p.ws + OFF_GW); const float* KD = (const float*)(p.ws + OFF_GKD);
  float* Sg = (float*)(p.ws + OFF_GS); const float* glast = (const float*)(p.ws + OFF_GLAST);
  const int ch0 = (b * 4 + hh) * 128;
  __syncthreads();
  *(float4*)(sS + tid * 4) = (float4){0.f, 0.f, 0.f, 0.f};
  float4 rw[4], rk[4], ru;
  { const float4* wp = (const float4*)(W + (size_t)ch0 * 4096); const float4* kp = (const float4*)(KD + (size_t)ch0 * 4096);
#pragma unroll
    for (int i = 0; i < 4; ++i) { rw[i] = gldf4(wp + tid + 256 * i); rk[i] = gldf4(kp + tid + 256 * i); }
    ru = gldf4(U + (size_t)ch0 * 4096 + c * 64 + sl * 16 + e4); }
  for (int n = 0; n < 128; ++n) {
    const int ch = ch0 + n;
    vm_wait0();
    __syncthreads();
#pragma unroll
    for (int i = 0; i < 4; ++i) { const int idx = (tid + 256 * i) * 4, rr = idx >> 6, cc = idx & 63;
      float* dw = sW + rr * 65 + cc; dw[0] = rw[i].x; dw[1] = rw[i].y; dw[2] = rw[i].z; dw[3] = rw[i].w;
      float* dk = sKD + rr * 65 + cc; dk[0] = rk[i].x; dk[1] = rk[i].y; dk[2] = rk[i].z; dk[3] = rk[i].w; }
    *(float4*)(sU + c * 16 + e4) = ru;
    const float gl = glast[ch];
    __syncthreads();
    if (n + 1 < 128) { const float4* wp = (const float4*)(W + (size_t)(ch + 1) * 4096); const float4* kp = (const float4*)(KD + (size_t)(ch + 1) * 4096);
#pragma unroll
      for (int i = 0; i < 4; ++i) { rw[i] = gldf4(wp + tid + 256 * i); rk[i] = gldf4(kp + tid + 256 * i); }
      ru = gldf4(U + (size_t)(ch + 1) * 4096 + c * 64 + sl * 16 + e4); }
    float4 acc = *(const float4*)(sU + c * 16 + e4);
#pragma unroll 8
    for (int d = 0; d < 64; ++d) { const float wv = sW[c * 65 + d]; const float4 sv = *(const float4*)(sS + d * 16 + e4);
      acc.x -= wv * sv.x; acc.y -= wv * sv.y; acc.z -= wv * sv.z; acc.w -= wv * sv.w; }
    *(float4*)(sV + c * 16 + e4) = acc;
    *(float4*)(U + (size_t)ch * 4096 + c * 64 + sl * 16 + e4) = acc;
    float4 sold = *(const float4*)(sS + c * 16 + e4);
    *(float4*)(Sg + (size_t)ch * 4096 + c * 64 + sl * 16 + e4) = sold;
    __syncthreads();
    sold.x *= gl; sold.y *= gl; sold.z *= gl; sold.w *= gl;
#pragma unroll 8
    for (int cc = 0; cc < 64; ++cc) { const float kv = sKD[cc * 65 + c]; const float4 vv = *(const float4*)(sV + cc * 16 + e4);
      sold.x += kv * vv.x; sold.y += kv * vv.y; sold.z += kv * vv.z; sold.w += kv * vv.w; }
    *(float4*)(sS + c * 16 + e4) = sold;
  }
}
DI void gdn_g3(const Params& p, int l, int ch, char* smem) {
  const int b = ch >> 9, hh = (ch >> 7) & 3, n = ch & 127, s0 = n * 64, tid = tid_(), c = tid >> 2, part = tid & 3;
  float* B1 = (float*)smem; float* B2 = B1 + 64 * 68; float* B3 = B2 + 64 * 68; float* sG = B3 + 64 * 68; float* sBeta = sG + 64;
  const float* Vn = (const float*)(p.ws + OFF_GU_) + (size_t)ch * 4096; const float* Sg = (const float*)(p.ws + OFF_GS) + (size_t)ch * 4096;
  __syncthreads();
  gdn_gates(p, l, b, hh, s0, sG, sBeta);
  gdn_conv(p, l, b, hh, s0, 0, B1, 68, true, 0.125f);
  gdn_conv(p, l, b, hh, s0, 1, B2, 68, true, 1.f);
  __syncthreads();
  const float Gc = sG[c];
  for (int i = 0; i < 16; ++i) { const int s = part + 4 * i; float a = 0.f;
    if (s <= c) { float dot = 0.f;
#pragma unroll
      for (int d4 = 0; d4 < 16; ++d4) { const float4 x = *(const float4*)(B1 + c * 68 + 4 * d4), y = *(const float4*)(B2 + s * 68 + 4 * d4); dot += (x.x * y.x + x.y * y.y) + (x.z * y.z + x.w * y.w); }
      a = dot * expf(Gc - sG[s]); }
    B3[c * 68 + s] = a; }
  __syncthreads();
#pragma unroll
  for (int i = 0; i < 4; ++i) { const int idx = (tid + 256 * i) * 4, rr = idx >> 6, cc = idx & 63; const float4 v = *(const float4*)(Sg + idx);
    *(float4*)(B2 + rr * 68 + cc) = v; }
  __syncthreads();
  float acc[16];
#pragma unroll
  for (int e = 0; e < 16; ++e) acc[e] = 0.f;
#pragma unroll 2
  for (int d4 = 0; d4 < 16; ++d4) { const float4 q4 = *(const float4*)(B1 + c * 68 + 4 * d4); const float qv[4] = {q4.x, q4.y, q4.z, q4.w};
#pragma unroll
    for (int dd = 0; dd < 4; ++dd)
#pragma unroll
      for (int e4 = 0; e4 < 4; ++e4) { const float4 bv = *(const float4*)(B2 + (4 * d4 + dd) * 68 + part * 16 + 4 * e4);
        acc[4 * e4] += qv[dd] * bv.x; acc[4 * e4 + 1] += qv[dd] * bv.y; acc[4 * e4 + 2] += qv[dd] * bv.z; acc[4 * e4 + 3] += qv[dd] * bv.w; } }
  { const float eg = expf(Gc);
#pragma unroll
    for (int e = 0; e < 16; ++e) acc[e] *= eg; }
  __syncthreads();
#pragma unroll
  for (int i = 0; i < 4; ++i) { const int idx = (tid + 256 * i) * 4, rr = idx >> 6, cc = idx & 63; const float4 v = *(const float4*)(Vn + idx);
    *(float4*)(B2 + rr * 68 + cc) = v; }
  __syncthreads();
#pragma unroll 2
  for (int s4 = 0; s4 < 16; ++s4) { const float4 i4 = *(const float4*)(B3 + c * 68 + 4 * s4); const float iv[4] = {i4.x, i4.y, i4.z, i4.w};
#pragma unroll
    for (int dd = 0; dd < 4; ++dd)
#pragma unroll
      for (int e4 = 0; e4 < 4; ++e4) { const float4 bv = *(const float4*)(B2 + (4 * s4 + dd) * 68 + part * 16 + 4 * e4);
        acc[4 * e4] += iv[dd] * bv.x; acc[4 * e4 + 1] += iv[dd] * bv.y; acc[4 * e4 + 2] += iv[dd] * bv.z; acc[4 * e4 + 3] += iv[dd] * bv.w; } }
  float ss = 0.f;
#pragma unroll
  for (int e = 0; e < 16; ++e) ss += acc[e] * acc[e];
  ss += __shfl_xor(ss, 1); ss += __shfl_xor(ss, 2);
  const float rn = rsqrtf(ss * (1.f / 64.f) + 1e-6f);
  const size_t tok = (size_t)(b * S_ + s0 + c);
  const bf16_t* zr = (const bf16_t*)(p.ws + OFF_BIG) + tok * LDP + C_GZ + hh * 64 + part * 16;
  bf16_t* mix = (bf16_t*)(p.ws + OFF_XB) + tok * D_ + 256 + hh * 64 + part * 16;
#pragma unroll
  for (int e = 0; e < 16; e += 2) {
    const float z0 = bf2f(zr[e]), z1 = bf2f(zr[e + 1]);
    const float y0 = acc[e] * rn * p.gdng[l * 64 + part * 16 + e] * (z0 / (1.f + __expf(-z0)));
    const float y1 = acc[e + 1] * rn * p.gdng[l * 64 + part * 16 + e + 1] * (z1 / (1.f + __expf(-z1)));
    *(unsigned*)(mix + e) = pack2(y0, y1);
  }
}

DI void nsa_compress(const Params& p, int l, int item, char* smem) {
  const int b = item >> 7, kv = (item >> 6) & 1, grp = item & 63, c0 = grp * 8, tok0 = c0 * 16, tid = tid_(), lane = tid & 63, wv = tid >> 6;
  const bf16_t* proj = (const bf16_t*)(p.ws + OFF_BIG) + (size_t)(b * S_) * LDP + (kv ? C_NVC : C_NKC);
  bf16_t* X = (bf16_t*)smem;
  float* Hp = (float*)(smem + 18432);
  __syncthreads();
  for (int idx = tid; idx < 144 * 8; idx += 256) { const int tk = idx >> 3, c = idx & 7, si = tok0 + tk;
    uint4 v = {0u, 0u, 0u, 0u}; if (si < S_) v = *(const uint4*)(proj + (size_t)si * LDP + c * 8);
    *(uint4*)(X + tk * 64 + c * 8) = v; }
  __syncthreads();
  const float* w1 = (kv ? p.cvw1 : p.ckw1) + (size_t)l * 2048 * 256 + lane * 4; const float* pe = (kv ? p.pev : p.pek) + (size_t)l * 2048;
  float acc[8][4], bias[4] = {0.f, 0.f, 0.f, 0.f};
#pragma unroll
  for (int r = 0; r < 8; ++r) { acc[r][0] = 0.f; acc[r][1] = 0.f; acc[r][2] = 0.f; acc[r][3] = 0.f; }
  const int i0 = wv * 512;
  for (int ib = 0; ib < 512; ib += 8) {
    f32x4 wr[8];
#pragma unroll
    for (int u = 0; u < 8; ++u) wr[u] = gldfv(w1 + (size_t)(i0 + ib + u) * 256);
    asm volatile("s_waitcnt vmcnt(0)" : "+v"(wr[0]), "+v"(wr[1]), "+v"(wr[2]), "+v"(wr[3]), "+v"(wr[4]), "+v"(wr[5]), "+v"(wr[6]), "+v"(wr[7]) :: "memory");
#pragma unroll
    for (int u = 0; u < 8; ++u) { const int i = i0 + ib + u, tk = i >> 6, d = i & 63; const float pv = pe[i]; const f32x4 w = wr[u];
      bias[0] += pv * w[0]; bias[1] += pv * w[1]; bias[2] += pv * w[2]; bias[3] += pv * w[3];
#pragma unroll
      for (int r = 0; r < 8; ++r) { const float xv = bf2f(X[(16 * r + tk) * 64 + d]); acc[r][0] += xv * w[0]; acc[r][1] += xv * w[1]; acc[r][2] += xv * w[2]; acc[r][3] += xv * w[3]; } }
  }
#pragma unroll
  for (int r = 0; r < 8; ++r) *(float4*)(Hp + (wv * 8 + r) * 256 + lane * 4) = (float4){acc[r][0] + bias[0], acc[r][1] + bias[1], acc[r][2] + bias[2], acc[r][3] + bias[3]};
  __syncthreads();
#pragma unroll
  for (int q = 0; q < 8; ++q) { const int idx = tid + 256 * q; const float hv = Hp[idx] + Hp[2048 + idx] + Hp[4096 + idx] + Hp[6144 + idx]; Hp[idx] = hv / (1.f + __expf(-hv)); }
  __syncthreads();
  const float* H = Hp;
  const float* w2 = (kv ? p.cvw2 : p.ckw2) + (size_t)l * 256 * 64;
  const int r0 = tid >> 6, d = tid & 63; float o0 = 0.f, o1 = 0.f;
  for (int jb = 0; jb < 256; jb += 16) { float w[16];
#pragma unroll
    for (int u = 0; u < 16; ++u) w[u] = gld32(w2 + (jb + u) * 64 + d);
    asm volatile("s_waitcnt vmcnt(0)" : "+v"(w[0]), "+v"(w[1]), "+v"(w[2]), "+v"(w[3]), "+v"(w[4]), "+v"(w[5]), "+v"(w[6]), "+v"(w[7]), "+v"(w[8]), "+v"(w[9]), "+v"(w[10]), "+v"(w[11]), "+v"(w[12]), "+v"(w[13]), "+v"(w[14]), "+v"(w[15]) :: "memory");
#pragma unroll
    for (int u = 0; u < 16; ++u) { o0 += H[r0 * 256 + jb + u] * w[u]; o1 += H[(r0 + 4) * 256 + jb + u] * w[u]; } }
  bf16_t* dst = (bf16_t*)(p.ws + (kv ? OFF_VCMP : OFF_KCMP)) + (size_t)b * (kv ? 64 * CLD : 512 * 64);
  { const int c1 = c0 + r0, c2 = c0 + r0 + 4; const float v1 = c1 < 511 ? o0 : 0.f, v2 = c2 < 511 ? o1 : 0.f;
    if (kv) { dst[d * CLD + c1] = f2bf(v1); dst[d * CLD + c2] = f2bf(v2); } else { dst[c1 * 64 + d] = f2bf(v1); dst[c2 * 64 + d] = f2bf(v2); } }
}
struct SelRegs { u32x4 ka[2], kb[2], v[4]; };
DI void sel_issue(SelRegs& rg, const bf16_t* kbase  , int kld, const bf16_t* vtbase  , int vld, int rowa, int l15, int quad) {
#pragma unroll
  for (int ks = 0; ks < 2; ++ks) { rg.ka[ks] = gldv(kbase + (size_t)rowa * kld + ks * 32 + quad * 8); rg.kb[ks] = gldv(kbase + (size_t)(rowa + 4) * kld + ks * 32 + quad * 8); }
#pragma unroll
  for (int dt = 0; dt < 4; ++dt) rg.v[dt] = gldv(vtbase + (size_t)(dt * 16 + l15) * vld + 8 * quad);
}
DI void sel_wait(SelRegs& rg) {
  asm volatile("s_waitcnt vmcnt(0)" : "+v"(rg.ka[0]), "+v"(rg.ka[1]), "+v"(rg.kb[0]), "+v"(rg.kb[1]), "+v"(rg.v[0]), "+v"(rg.v[1]), "+v"(rg.v[2]), "+v"(rg.v[3]) :: "memory");
}
DI void sel_compute(const SelRegs& rg, const bf16x8 (&qf)[2], int kb0, bool colsel, int stk, int quad, float& m, float& lsum, f32x4 (&Os)[4]) {
  f32x4 sa = {0.f, 0.f, 0.f, 0.f}, sb = {0.f, 0.f, 0.f, 0.f};
#pragma unroll
  for (int ks = 0; ks < 2; ++ks) { sa = MFMA16(__builtin_bit_cast(bf16x8, rg.ka[ks]), qf[ks], sa); sb = MFMA16(__builtin_bit_cast(bf16x8, rg.kb[ks]), qf[ks], sb); }
  float mx = m;
#pragma unroll
  for (int i = 0; i < 4; ++i) { const int ka = kb0 + 8 * quad + i;
    const float va = (colsel && ka <= stk) ? sa[i] * 0.125f : -1e30f, vb = (colsel && ka + 4 <= stk) ? sb[i] * 0.125f : -1e30f;
    sa[i] = va; sb[i] = vb; mx = fmaxf(mx, fmaxf(va, vb)); }
  mx = fmaxf(mx, __shfl_xor(mx, 16)); mx = fmaxf(mx, __shfl_xor(mx, 32));
  const float corr = fexp(m - mx); m = mx; float ps = 0.f;
#pragma unroll
  for (int i = 0; i < 4; ++i) { const float pa = sa[i] > -1e29f ? fexp(sa[i] - mx) : 0.f, pb = sb[i] > -1e29f ? fexp(sb[i] - mx) : 0.f; sa[i] = pa; sb[i] = pb; ps += pa + pb; }
  lsum = lsum * corr + ps;
  bf16x8 pf;
#pragma unroll
  for (int i = 0; i < 4; ++i) { pf[i] = (short)f2bf(sa[i]); pf[4 + i] = (short)f2bf(sb[i]); }
#pragma unroll
  for (int dt = 0; dt < 4; ++dt) { Os[dt][0] *= corr; Os[dt][1] *= corr; Os[dt][2] *= corr; Os[dt][3] *= corr; Os[dt] = MFMA16(__builtin_bit_cast(bf16x8, rg.v[dt]), pf, Os[dt]); }
}
DI void nsa_group(const Params& p, int t0, float* wl) {
  const int lane = tid_() & 63, l15 = lane & 15, quad = lane >> 4, tk = l15 >> 2, hd = l15 & 3;
  const int b = t0 >> 13, s0 = t0 & (S_ - 1), cur = s0 >> 6, stk = s0 + tk;
  const bf16_t* projb = (const bf16_t*)(p.ws + OFF_BIG) + (size_t)(b * S_) * LDP;
  const bf16_t* kc = (const bf16_t*)(p.ws + OFF_KCMP) + (size_t)b * 512 * 64; const bf16_t* vcT = (const bf16_t*)(p.ws + OFF_VCMP) + (size_t)b * 64 * CLD;
  const bf16_t* vsT = (const bf16_t*)(p.ws + OFF_VT) + (size_t)(9 * 64) * VLD + b * S_;
  float* Gs = wl; float* Cs = wl + 4 * 132; int* blist = (int*)(wl + 8 * 132);
  WAVE_SYNC();
  for (int i = lane; i < 8 * 132; i += 64) wl[i] = 0.f;
  bf16x8 qf[2];
#pragma unroll
  for (int ks = 0; ks < 2; ++ks) qf[ks] = *(const bf16x8*)(projb + (size_t)stk * LDP + C_NQ + hd * 64 + ks * 32 + quad * 8);
  const int ncv = stk >= 31 ? ((stk - 31) >> 4) + 1 : 0, ncvmax = (s0 + 3 >= 31) ? ((s0 + 3 - 31) >> 4) + 1 : 0, nstep = (ncvmax + 31) >> 5;
  const int rowa = (l15 >> 2) * 8 + (l15 & 3);
  float m = -1e30f, lsum = 0.f;
  SelRegs c0r, c1r;
  f32x4 Oc[4];
#pragma unroll
  for (int dt = 0; dt < 4; ++dt) Oc[dt] = (f32x4){0.f, 0.f, 0.f, 0.f};
#define CMP_SCORES(rg_, cbase_) \
    f32x4 sa = {0.f, 0.f, 0.f, 0.f}, sb = {0.f, 0.f, 0.f, 0.f}; \
    _Pragma("unroll") for (int ks = 0; ks < 2; ++ks) { sa = MFMA16(__builtin_bit_cast(bf16x8, rg_.ka[ks]), qf[ks], sa); sb = MFMA16(__builtin_bit_cast(bf16x8, rg_.kb[ks]), qf[ks], sb); }
#define CMP_P1(rg_, cbase_) { CMP_SCORES(rg_, cbase_) float mx = m; \
    _Pragma("unroll") for (int i = 0; i < 4; ++i) { const int ca = (cbase_) + 8 * quad + i; const float va = ca < ncv ? sa[i] * 0.125f : -1e30f, vb = ca + 4 < ncv ? sb[i] * 0.125f : -1e30f; sa[i] = va; sb[i] = vb; mx = fmaxf(mx, fmaxf(va, vb)); } \
    mx = fmaxf(mx, __shfl_xor(mx, 16)); mx = fmaxf(mx, __shfl_xor(mx, 32)); \
    const float corr = fexp(m - mx); m = mx; float ps = 0.f; \
    _Pragma("unroll") for (int i = 0; i < 4; ++i) ps += (sa[i] > -1e29f ? fexp(sa[i] - mx) : 0.f) + (sb[i] > -1e29f ? fexp(sb[i] - mx) : 0.f); \
    lsum = lsum * corr + ps; }
#define CMP_P2(rg_, cbase_) { CMP_SCORES(rg_, cbase_) float ga = 0.f, gb = 0.f; \
    _Pragma("unroll") for (int i = 0; i < 4; ++i) { const int ca = (cbase_) + 8 * quad + i; const float pa = ca < ncv ? fexp(sa[i] * 0.125f - m) * inv : 0.f, pb = ca + 4 < ncv ? fexp(sb[i] * 0.125f - m) * inv : 0.f; \
      sa[i] = pa; sb[i] = pb; ga += pa; gb += pb; } \
    float ca3 = sa[3], cb3 = sb[3]; \
    ga += __shfl_xor(ga, 1); ga += __shfl_xor(ga, 2); gb += __shfl_xor(gb, 1); gb += __shfl_xor(gb, 2); \
    ca3 += __shfl_xor(ca3, 1); ca3 += __shfl_xor(ca3, 2); cb3 += __shfl_xor(cb3, 1); cb3 += __shfl_xor(cb3, 2); \
    if (hd == 0) { const int j = ((cbase_) >> 2) + 2 * quad; Gs[tk * 132 + j] = ga; Gs[tk * 132 + j + 1] = gb; Cs[tk * 132 + j + 1] = ca3; Cs[tk * 132 + j + 2] = cb3; } \
    bf16x8 pf; \
    _Pragma("unroll") for (int i = 0; i < 4; ++i) { pf[i] = (short)f2bf(sa[i]); pf[4 + i] = (short)f2bf(sb[i]); } \
    _Pragma("unroll") for (int dt = 0; dt < 4; ++dt) Oc[dt] = MFMA16(__builtin_bit_cast(bf16x8, rg_.v[dt]), pf, Oc[dt]); }
#define CMP_ISSUE(rg_, st_) sel_issue(rg_, kc + (size_t)((st_) * 32) * 64, 64, vcT + (st_) * 32, CLD, rowa, l15, quad)
  if (nstep > 0) {
    CMP_ISSUE(c0r, 0);
    for (int st = 0; st < nstep; st += 2) {
      sel_wait(c0r); CMP_ISSUE(c1r, (st + 1 < nstep ? st + 1 : st)); CMP_P1(c0r, st * 32)
      sel_wait(c1r); CMP_ISSUE(c0r, (st + 2 < nstep ? st + 2 : 0)); if (st + 1 < nstep) CMP_P1(c1r, (st + 1) * 32)
    }
    sel_wait(c0r);
  }
  lsum += __shfl_xor(lsum, 16); lsum += __shfl_xor(lsum, 32);
  const float inv = lsum > 0.f ? 1.f / lsum : 0.f;
  WAVE_SYNC();
  if (nstep > 0) {
    for (int st = 0; st < nstep; st += 2) {
      sel_wait(c0r); CMP_ISSUE(c1r, (st + 1 < nstep ? st + 1 : st)); CMP_P2(c0r, st * 32)
      sel_wait(c1r); CMP_ISSUE(c0r, (st + 2 < nstep ? st + 2 : st)); if (st + 1 < nstep) CMP_P2(c1r, (st + 1) * 32)
    }
    sel_wait(c0r);
  }
#undef CMP_SCORES
#undef CMP_P1
#undef CMP_P2
#undef CMP_ISSUE
  WAVE_SYNC();
  for (int i = lane; i < 512; i += 64) { const int t2 = i >> 7, j = i & 127; const bool valid = j <= cur, forced = valid && (j == 0 || j == cur || j == cur - 1);
    const float im = Gs[t2 * 132 + j] + Cs[t2 * 132 + j]; Gs[t2 * 132 + j] = forced ? 1e4f : (valid ? im : -1e4f); }
  WAVE_SYNC();
  unsigned long long mlo[4] = {0ull, 0ull, 0ull, 0ull}, mhi[4] = {0ull, 0ull, 0ull, 0ull};
  if (cur < 16) {
#pragma unroll
    for (int t2 = 0; t2 < 4; ++t2) mlo[t2] = (1ull << (cur + 1)) - 1ull;
  } else {
    const int tkr = lane >> 4, sub = lane & 15; float v[8]; int rank[8];
#pragma unroll
    for (int mm = 0; mm < 8; ++mm) { v[mm] = Gs[tkr * 132 + sub + 16 * mm]; rank[mm] = 0; }
#pragma unroll 8
    for (int j2 = 0; j2 <= cur; ++j2) { const float o = Gs[tkr * 132 + j2];
#pragma unroll
      for (int mm = 0; mm < 8; ++mm) rank[mm] += (o > v[mm] || (o == v[mm] && j2 < sub + 16 * mm)) ? 1 : 0; }
#pragma unroll
    for (int mm = 0; mm < 8; ++mm) { const unsigned long long bal = __ballot((sub + 16 * mm <= cur) && rank[mm] < 16);
#pragma unroll
      for (int t2 = 0; t2 < 4; ++t2) { const unsigned long long field = (bal >> (16 * t2)) & 0xffffull; if (mm < 4) mlo[t2] |= field << (16 * mm); else mhi[t2] |= field << (16 * (mm - 4)); } }
  }
  const unsigned long long ulo = mlo[0] | mlo[1] | mlo[2] | mlo[3], uhi = mhi[0] | mhi[1] | mhi[2] | mhi[3];
  const int nlo = __popcll(ulo), nblk = nlo + __popcll(uhi);
  { const unsigned long long below = (1ull << lane) - 1ull;
    if ((ulo >> lane) & 1ull) { int tm = 0;
#pragma unroll
      for (int t2 = 0; t2 < 4; ++t2) tm |= (int)((mlo[t2] >> lane) & 1ull) << t2;
      blist[__popcll(ulo & below)] = lane | (tm << 8); }
    if ((uhi >> lane) & 1ull) { int tm = 0;
#pragma unroll
      for (int t2 = 0; t2 < 4; ++t2) tm |= (int)((mhi[t2] >> lane) & 1ull) << t2;
      blist[nlo + __popcll(uhi & below)] = (lane + 64) | (tm << 8); } }
  WAVE_SYNC();
  float m2 = -1e30f, l2 = 0.f; f32x4 Os[4];
#pragma unroll
  for (int dt = 0; dt < 4; ++dt) Os[dt] = (f32x4){0.f, 0.f, 0.f, 0.f};
  const int nh = 2 * nblk;
  SelRegs r0, r1;
  { const int e0 = __builtin_amdgcn_readfirstlane(blist[0]); sel_issue(r0, projb + (size_t)((e0 & 255) * 64) * LDP + C_NKS, LDP, vsT + (e0 & 255) * 64, VLD, rowa, l15, quad); }
  for (int hs = 0; hs < nh; hs += 2) {
    const int e = __builtin_amdgcn_readfirstlane(blist[hs >> 1]); const int kb0 = (e & 255) * 64; const bool colsel = ((e >> (8 + tk)) & 1) != 0;
    sel_wait(r0);
    sel_issue(r1, projb + (size_t)(kb0 + 32) * LDP + C_NKS, LDP, vsT + kb0 + 32, VLD, rowa, l15, quad);
    sel_compute(r0, qf, kb0, colsel, stk, quad, m2, l2, Os);
    sel_wait(r1);
    { const int en = __builtin_amdgcn_readfirstlane(blist[(hs + 2 < nh ? hs + 2 : hs) >> 1]); sel_issue(r0, projb + (size_t)((en & 255) * 64) * LDP + C_NKS, LDP, vsT + (en & 255) * 64, VLD, rowa, l15, quad); }
    sel_compute(r1, qf, kb0 + 32, colsel, stk, quad, m2, l2, Os);
  }
  sel_wait(r0);
  l2 += __shfl_xor(l2, 16); l2 += __shfl_xor(l2, 32);
  const float inv2 = 1.f / l2;
  const size_t tok = (size_t)(b * S_ + stk);
  const bf16_t* prow = projb + (size_t)stk * LDP;
  const float g0 = 1.f / (1.f + __expf(-bf2f(prow[C_NG + hd * 3]))), g1 = 1.f / (1.f + __expf(-bf2f(prow[C_NG + hd * 3 + 1]))), g2 = 1.f / (1.f + __expf(-bf2f(prow[C_NG + hd * 3 + 2])));
  const bf16_t* ow = (const bf16_t*)(p.ws + OFF_OWIN) + tok * 256 + hd * 64; bf16_t* mix = (bf16_t*)(p.ws + OFF_XB) + tok * D_ + 512 + hd * 64;
#pragma unroll
  for (int dt = 0; dt < 4; ++dt) { const int dv = dt * 16 + 4 * quad; const uint2 wv = *(const uint2*)(ow + dv);
    const float w0 = __uint_as_float(wv.x << 16), w1 = __uint_as_float(wv.x & 0xffff0000u), w2 = __uint_as_float(wv.y << 16), w3 = __uint_as_float(wv.y & 0xffff0000u);
    uint2 pk; pk.x = pack2(g0 * Oc[dt][0] + g1 * Os[dt][0] * inv2 + g2 * w0, g0 * Oc[dt][1] + g1 * Os[dt][1] * inv2 + g2 * w1);
    pk.y = pack2(g0 * Oc[dt][2] + g1 * Os[dt][2] * inv2 + g2 * w2, g0 * Oc[dt][3] + g1 * Os[dt][3] * inv2 + g2 * w3);
    *(uint2*)(mix + dv) = pk; }
}

DI int q_pop(unsigned* ctr, char* smem) {
  int* sh = (int*)(smem + 65024);
  __syncthreads();
  if (tid_() == 0) *sh = (int)atomicAdd(ctr, 1u);
  __syncthreads();
  return *sh;
}
DI void m1_phase(const Params& p, int l, char* smem, int cslot = 0, int skip = 0) {
  unsigned* ctr = (unsigned*)(p.ws + OFF_CNT) + cslot;
  const int total = 32 + 64 * 24 + 256;
  bool first = true;
  for (;;) {
    const int it = (first ? (int)blockIdx.x : q_pop(ctr, smem) + (int)gridDim.x) + skip; first = false;
    if (it >= total) break;
#ifndef M1SEL
#define M1SEL 31
#endif
    if (it < 32) { if (M1SEL & 1) gdn_chain(p, it, smem); }
    else if (it < 32 + 256) { if (M1SEL & 16) nsa_compress(p, l, it - 32, smem); }
    else { const int j = it - 288, qb = 63 - j / 24, k = j % 24, kind = k >> 3, bh = k & 7, b = bh >> 2, hh = bh & 3;
      if (kind == 0) { if (M1SEL & 2) sb_item(p, b, hh, qb, smem); } else if (kind == 1) { if (M1SEL & 4) diff_item(p, l, b, hh, qb, smem); } else { if (M1SEL & 8) win_item(p, b, hh, qb, smem); } }
  }
}
DI void m2_phase(const Params& p, int l, char* smem, int cslot = 16) {
  unsigned* ctr = (unsigned*)(p.ws + OFF_CNT) + cslot;
  const int total = 1024, wave = tid_() >> 6;
  for (int it = blockIdx.x; it < 1024; it += gridDim.x) gdn_g3(p, l, it, smem);
  bool first = true;
  for (;;) {
    const int it = first ? (int)blockIdx.x : q_pop(ctr, smem) + (int)gridDim.x;
    if (first) __syncthreads();
    first = false;
    if (it >= total) break;
    nsa_group(p, it * 16 + wave * 4, (float*)smem + wave * 1152);
  }
}

struct XB { unsigned x, nloc, nx; };
#define XB_XCNT(j) (64 * (j))
#define XB_XSUB(j) (64 * (16 + (j)))
#define XB_XGEN(j) (64 * (32 + (j)))
#define XB_TOP (64 * 48)
#define XB_TOPGEN (64 * 49)
DI unsigned xb_ld(unsigned* p) { return __hip_atomic_load(p, __ATOMIC_RELAXED, __HIP_MEMORY_SCOPE_AGENT); }
DI unsigned xb_add(unsigned* p, unsigned v) { return __hip_atomic_fetch_add(p, v, __ATOMIC_RELAXED, __HIP_MEMORY_SCOPE_AGENT); }
DI unsigned xb_xcc_id() { return (unsigned)__builtin_amdgcn_s_getreg((3 << 11) | 20) & 0xFu; }
#define XB_SPIN(cond) do { unsigned sp_ = 0; while ((cond) && ++sp_ < (1u << 24)) __builtin_amdgcn_s_sleep(1); } while (0)
DI void xcd_barrier(unsigned* bar, const XB& b) {
  asm volatile("s_waitcnt vmcnt(0)" ::: "memory");
  __syncthreads();
  if (tid_() == 0) {
    asm volatile("s_waitcnt vmcnt(0) lgkmcnt(0)" ::: "memory");
    const unsigned old = xb_add(bar + XB_XSUB(b.x), 1u), gen = old / b.nloc;
    if (old + 1u == (gen + 1u) * b.nloc) {
      __builtin_amdgcn_fence(__ATOMIC_RELEASE, "agent");
      asm volatile("s_waitcnt vmcnt(0)" ::: "memory");
      const unsigned og = xb_add(bar + XB_TOP, 1u), tg = og / b.nx;
      if (og + 1u == (tg + 1u) * b.nx) xb_add(bar + XB_TOPGEN, 1u);
      else XB_SPIN(xb_ld(bar + XB_TOPGEN) == tg);
      __builtin_amdgcn_fence(__ATOMIC_ACQUIRE, "agent");
      xb_add(bar + XB_XGEN(b.x), 1u);
      asm volatile("s_waitcnt vmcnt(0)" ::: "memory");
    } else {
      XB_SPIN(xb_ld(bar + XB_XGEN(b.x)) == gen);
      __builtin_amdgcn_fence(__ATOMIC_ACQUIRE, "agent");
      asm volatile("s_waitcnt vmcnt(0)" ::: "memory");
    }
  }
  __syncthreads();
}
constexpr int NPHASE = 25;
DI void run_phase(const Params& p, int ph, char* smem) {
  if (ph == 0) { prologue_phase(p); convert_weights(p, 0, 1, smem); return; }
  const int l = (ph - 1) / 12, sp = (ph - 1) % 12;
  const float alpha = 1.4142135623730951f;
  bf16_t* xb = (bf16_t*)(p.ws + OFF_XB); bf16_t* big = (bf16_t*)(p.ws + OFF_BIG);
  const bf16_t* wgu = (const bf16_t*)(p.ws + OFF_GU); const bf16_t* wdn = (const bf16_t*)(p.ws + OFF_DN);
  EpiArgs e; e.obf = big; e.resid = p.out; e.of32 = p.out; e.alpha = alpha; e.sc = 0.5f; e.rope = (const float*)(p.ws + OFF_ROPE);
  switch (sp) {
    case 0: case 9: gemm_phase<0>(xb, D_, wgu, D_, 2 * DFF, smem, e); break;
    case 1: if (l == 0) e.resid = p.x; gemm_phase<2>(big, DFF, wdn, DFF, D_, smem, e); break;
    case 10: gemm_phase<2>(big, DFF, wdn, DFF, D_, smem, e); break;
    case 2: ln_phase(p.out, xb, p.ln1g + l * D_, p.ln1b + l * D_); break;
    case 3: gemm_phase<1>(xb, D_, (const bf16_t*)(p.ws + OFF_WIN), D_, LDP, smem, e); break;
    case 4: m0_phase(p, l, smem); break;
    case 5: m1_phase(p, l, smem); break;
    case 6: m2_phase(p, l, smem); break;
    case 7: e.sc = 1.f; gemm_phase<2>(xb, D_, (const bf16_t*)(p.ws + OFF_WOUT), D_, D_, smem, e); break;
    case 8: ln_phase(p.out, xb, p.ln2g + l * D_, p.ln2b + l * D_); convert_weights(p, l, 2, smem); break;
    case 11: ln_phase(p.out, xb, p.ln3g + l * D_, p.ln3b + l * D_); if (l + 1 < 2) convert_weights(p, l + 1, 1, smem); break;
  }
}
__global__ void __launch_bounds__(256, 2) mega(Params p, int ph0, int ph1, int coop) {
  __shared__ __attribute__((aligned(16))) char smem[65536];
#ifdef PHASE_ONLY
  run_phase(p, PHASE_ONLY, smem); return;
#endif
  XB xb; xb.x = xb_xcc_id(); xb.nloc = 1u; xb.nx = 1u;
  unsigned* bar = (unsigned*)(p.ws + OFF_BAR);
  if (coop && tid_() == 0) xb_add(bar + XB_XCNT(xb.x), 1u);
  for (int ph = ph0; ph < ph1; ++ph) {
    const Params& q = p;
    run_phase(q, ph, smem);
#ifdef PROBE_DUP
    { const int sp = (ph - 1) % 12; const int l = (ph - 1) / 12;
      if (ph > 0 && PROBE_DUP == 1 && (sp == 0 || sp == 9)) { cg::this_grid().sync(); run_phase(q, ph, smem); }
      if (ph > 0 && PROBE_DUP == 2 && sp == 5) { cg::this_grid().sync(); m1_phase(q, l, smem, 32, 32); }
      if (ph > 0 && PROBE_DUP == 3 && sp == 6) { cg::this_grid().sync(); m2_phase(q, l, smem, 48); }
      if (ph > 0 && PROBE_DUP == 6 && sp == 6) { cg::this_grid().sync(); for (int it = blockIdx.x; it < 1024; it += gridDim.x) gdn_g3(q, l, it, smem); }
      if (ph > 0 && PROBE_DUP == 7 && sp == 4) { cg::this_grid().sync(); for (int it = blockIdx.x; it < 2560; it += gridDim.x) vt_tile(q, it, smem); }
      if (PROBE_DUP == 8 && ph < 20) { cg::this_grid().sync(); cg::this_grid().sync(); }
      if (ph > 0 && PROBE_DUP == 4 && sp == 3) { cg::this_grid().sync(); run_phase(q, ph, smem); }
      if (ph > 0 && PROBE_DUP == 5 && sp == 4) { cg::this_grid().sync(); for (int it = blockIdx.x; it < 2560 + 1024; it += gridDim.x) { if (it < 1024) gdn_g1(q, l, it, smem); else vt_tile(q, it - 1024, smem); } } }
#endif
    if (coop && ph + 1 < ph1) {
      if (ph == 0) { cg::this_grid().sync();
        unsigned mine = 0u, cnt = 0u;
        for (unsigned j = 0; j < 16; ++j) { const unsigned c = xb_ld(bar + XB_XCNT(j)); cnt += c > 0u ? 1u : 0u; mine = (j == xb.x) ? c : mine; }
        xb.nloc = mine > 0u ? mine : 1u; xb.nx = cnt > 0u ? cnt : 1u; }
      else xcd_barrier(bar, xb);
    }
  }
}

extern "C" void kernel_launch(void* const* d_in, const int* in_sizes, int n_in, void* d_out, int out_size, void* d_ws, size_t ws_size, hipStream_t stream) {
  Params p{};
  const float** f = (const float**)&p;
  for (int i = 0; i < 28; ++i) f[i] = (const float*)d_in[i];
  p.out = (float*)d_out; p.ws = (char*)d_ws;
  static int grid_blocks = 0;
  if (!grid_blocks) {
    int dev = 0, cus = 0, per_cu = 0;
    hipGetDevice(&dev);
    hipDeviceGetAttribute(&cus, hipDeviceAttributeMultiprocessorCount, dev);
    hipOccupancyMaxActiveBlocksPerMultiprocessor(&per_cu, mega, 256, 0);
    if (per_cu < 1) per_cu = 1;
    if (per_cu > 2) per_cu = 2;
    grid_blocks = cus * per_cu;
  }
  if (ws_size < WS_NEED) { fprintf(stderr, "workspace too small: %zu < %zu\n", ws_size, (size_t)WS_NEED); return; }
#if MK_COOP
  hipMemsetAsync((char*)d_ws + OFF_BAR, 0, 32768, stream);
  int ph0 = 0, ph1 = NPHASE, coop = 1;
  void* args[] = {&p, &ph0, &ph1, &coop};
  hipError_t e = hipLaunchCooperativeKernel((void*)mega, dim3(grid_blocks), dim3(256), args, 0, stream);
  if (e != hipSuccess) fprintf(stderr, "cooperative launch failed: %s (grid %d)\n", hipGetErrorString(e), grid_blocks);
#else
  for (int ph = 0; ph < NPHASE; ++ph) hipLaunchKernelGGL(mega, dim3(grid_blocks), dim3(256), 0, stream, p, ph, ph + 1, 0);
#endif
}
```

```cpp
#include <hip/hip_runtime.h>
#include <hip/hip_cooperative_groups.h>
#include <stdint.h>
#include <cstdio>
namespace cg = cooperative_groups;

#ifndef MK_COOP
#define MK_COOP 1
#endif

#define DI __device__ __forceinline__
typedef unsigned short bf16_t;
typedef short bf16x8 __attribute__((ext_vector_type(8)));
typedef short s16x4 __attribute__((ext_vector_type(4)));
typedef float f32x4 __attribute__((ext_vector_type(4)));
typedef float f32x16 __attribute__((ext_vector_type(16)));
typedef unsigned u32x4 __attribute__((ext_vector_type(4)));

constexpr int T_ = 16384, S_ = 8192, D_ = 1024, DFF = 2816, LDP = 3328;
constexpr int VLD = T_ + 128;
constexpr int CLD = 544;
constexpr int C_DQ1 = 0, C_DQ2 = 128, C_DK1 = 256, C_DK2 = 384, C_DV = 512, C_GQ = 768, C_GK = 1024, C_GV = 1280, C_GZ = 1536,
              C_NQ = 1792, C_NKC = 2048, C_NVC = 2112, C_NKS = 2176, C_NVS = 2240, C_NKW = 2304, C_NVW = 2368,
              C_SQ = 2432, C_SK = 2688, C_SV = 2944, C_GA = 3200, C_GB = 3204, C_NG = 3208;

constexpr size_t OFF_GU = 0, OFF_DN = 11534336, OFF_WIN = OFF_DN + 5767168, OFF_WOUT = OFF_WIN + 6815744;
constexpr size_t OFF_VT = 0;
constexpr size_t OFF_XB = OFF_WOUT + 2097152;
constexpr size_t OFF_BIG = OFF_XB + 33554432;
constexpr size_t OFF_GU_ = OFF_BIG + 109051904;
constexpr size_t OFF_GW = OFF_GU_ + 16777216, OFF_GKD = OFF_GW + 16777216, OFF_GS = OFF_GKD + 16777216;
constexpr size_t OFF_OWIN = OFF_GS + 16777216;
constexpr size_t OFF_ROPE = OFF_OWIN + 8388608;
constexpr size_t OFF_KCMP = OFF_ROPE + 3145728, OFF_VCMP = OFF_KCMP + 262144;
constexpr size_t OFF_GLAST = OFF_VCMP + 262144;
constexpr size_t OFF_CNT = OFF_GLAST + 4096;
constexpr size_t OFF_BAR = OFF_CNT + 512;
constexpr size_t WS_NEED = OFF_BAR + 32768;

struct Params {
  const float *x, *w_in, *w_out, *gu1, *dn1, *gu2, *dn2;
  const float *ln1g, *ln1b, *ln2g, *ln2b, *ln3g, *ln3b;
  const float *lq1, *lk1, *lq2, *lk2, *subln;
  const float *convw, *alog, *dtb, *gdng;
  const float *pek, *pev, *ckw1, *ckw2, *cvw1, *cvw2;
  float* out; char* ws;
};

DI int tid_() { int t = __builtin_amdgcn_workitem_id_x(); asm volatile("" : "+v"(t)); return t; }
DI float bf2f(bf16_t v) { return __uint_as_float(((unsigned)v) << 16); }
DI bf16_t f2bf(float f) { unsigned u = __float_as_uint(f); u += 0x7fffu + ((u >> 16) & 1u); return (bf16_t)(u >> 16); }
DI unsigned pack2(float a, float b) { return (unsigned)f2bf(a) | ((unsigned)f2bf(b) << 16); }
DI float fexp2(float x) { return __builtin_amdgcn_exp2f(x); }
DI float fexp(float x) { return __builtin_amdgcn_exp2f(x * 1.4426950408889634f); }
DI float flog(float x) { return __builtin_amdgcn_logf(x) * 0.6931471805599453f; }
DI float wave_max(float v) { for (int o = 32; o >= 1; o >>= 1) v = fmaxf(v, __shfl_xor(v, o)); return v; }
DI float wave_sum(float v) { for (int o = 32; o >= 1; o >>= 1) v += __shfl_xor(v, o); return v; }
#define WAVE_SYNC() do { __builtin_amdgcn_fence(__ATOMIC_RELEASE, "wavefront"); __builtin_amdgcn_wave_barrier(); __builtin_amdgcn_fence(__ATOMIC_ACQUIRE, "wavefront"); } while (0)
DI uint4 gld16(const void* p) { uint4 r; asm volatile("global_load_dwordx4 %0, %1, off" : "=v"(r) : "v"(p) : "memory"); return r; }
DI float4 gldf4(const void* p) { float4 r; asm volatile("global_load_dwordx4 %0, %1, off" : "=v"(r) : "v"(p) : "memory"); return r; }
DI u32x4 gldv(const void* p) { u32x4 r; asm volatile("global_load_dwordx4 %0, %1, off" : "=v"(r) : "v"(p) : "memory"); return r; }
DI f32x4 gldfv(const void* p) { f32x4 r; asm volatile("global_load_dwordx4 %0, %1, off" : "=v"(r) : "v"(p) : "memory"); return r; }
DI float gld32(const void* p) { float r; asm volatile("global_load_dword %0, %1, off" : "=v"(r) : "v"(p) : "memory"); return r; }
DI void vm_wait0() { asm volatile("s_waitcnt vmcnt(0)" ::: "memory"); }
DI int crow(int i, int h) { return (i & 3) + 8 * (i >> 2) + 4 * h; }
#define MFMA16(a, b, c) __builtin_amdgcn_mfma_f32_16x16x32_bf16((a), (b), (c), 0, 0, 0)
#define MFMA32(a, b, c) __builtin_amdgcn_mfma_f32_32x32x16_bf16((a), (b), (c), 0, 0, 0)

DI int src_col(int n, int mode) {
  if (mode == 1) { int t16 = n >> 4; return (t16 & 1) * DFF + (t16 >> 1) * 16 + (n & 15); }
  if (mode == 2) {
    if (n < 1792) return n;
    if (n < 2432) return n + 8;
    if (n < 3200) return n + 20;
    if (n < 3208) return 1792 + (n - 3200);
    if (n < 3220) return 2440 + (n - 3208);
    return -1;
  }
  return n;
}
DI void conv_tile(const float* __restrict__ W, int K, int N, bf16_t* __restrict__ Wt, int mode, int tile, char* smem) {
  float* tl = (float*)smem;
  const int nK = K >> 6, kt = tile % nK, nt = tile / nK, k0 = kt * 64, n0 = nt * 64, tid = tid_();
  __syncthreads();
  { const int c = tid & 63, sc = src_col(n0 + c, mode); const int scc = sc >= 0 ? sc : 0; float wv[16];
#pragma unroll
    for (int i = 0; i < 16; ++i) wv[i] = gld32(W + (size_t)(k0 + (tid >> 6) + 4 * i) * N + scc);
    asm volatile("s_waitcnt vmcnt(0)" : "+v"(wv[0]), "+v"(wv[1]), "+v"(wv[2]), "+v"(wv[3]), "+v"(wv[4]), "+v"(wv[5]), "+v"(wv[6]), "+v"(wv[7]), "+v"(wv[8]), "+v"(wv[9]), "+v"(wv[10]), "+v"(wv[11]), "+v"(wv[12]), "+v"(wv[13]), "+v"(wv[14]), "+v"(wv[15]) :: "memory");
#pragma unroll
    for (int i = 0; i < 16; ++i) { const int r = (tid >> 6) + 4 * i; tl[r * 65 + c] = (sc >= 0) ? wv[i] : 0.f; } }
  __syncthreads();
  { const int kk2 = (tid & 31) * 2;
#pragma unroll
    for (int i = 0; i < 8; ++i) { const int nn = (tid >> 5) + 8 * i; *(unsigned*)(Wt + (size_t)(n0 + nn) * K + k0 + kk2) = pack2(tl[kk2 * 65 + nn], tl[(kk2 + 1) * 65 + nn]); } }
}
DI void convert_weights(const Params& p, int l, int which  , char* smem) {
  bf16_t* gu = (bf16_t*)(p.ws + OFF_GU); bf16_t* dn = (bf16_t*)(p.ws + OFF_DN);
  const float* sgu = (which == 1 ? p.gu1 : p.gu2) + (size_t)l * D_ * 2 * DFF;
  const float* sdn = (which == 1 ? p.dn1 : p.dn2) + (size_t)l * DFF * D_;
  const int n_gu = 16 * 88, n_dn = 44 * 16, n_in = (which == 1) ? 16 * 52 : 0, n_out = (which == 1) ? 256 : 0;
  const int total = n_gu + n_dn + n_in + n_out;
  for (int it = blockIdx.x; it < total; it += gridDim.x) {
    if (it < n_gu) conv_tile(sgu, D_, 2 * DFF, gu, 1, it, smem);
    else if (it < n_gu + n_dn) conv_tile(sdn, DFF, D_, dn, 0, it - n_gu, smem);
    else if (it < n_gu + n_dn + n_in) conv_tile(p.w_in + (size_t)l * D_ * 3220, D_, 3220, (bf16_t*)(p.ws + OFF_WIN), 2, it - n_gu - n_dn, smem);
    else conv_tile(p.w_out + (size_t)l * D_ * D_, D_, D_, (bf16_t*)(p.ws + OFF_WOUT), 0, it - n_gu - n_dn - n_in, smem);
  }
}

struct EpiArgs { bf16_t* obf; const float* resid; float* of32; float alpha, sc; const float* rope; };
DI void vm_wait8() { asm volatile("s_waitcnt vmcnt(8)" ::: "memory"); }
template <int EPI>
DI void gemm_epilogue(f32x4 (&acc)[4][4], int m0, int n0, int wm, int wn, int l15, int quad, const EpiArgs& e) {
#pragma unroll
  for (int mt = 0; mt < 4; ++mt) {
    const size_t row = (size_t)(m0 + wm * 64 + mt * 16 + l15);
    if (EPI == 0) {
#pragma unroll
      for (int q = 0; q < 2; ++q) {
        const int j = ((n0 >> 5) + wn * 2 + q) * 16 + 4 * quad; float hv[4];
#pragma unroll
        for (int i = 0; i < 4; ++i) { const float g = acc[mt][2 * q][i], u = acc[mt][2 * q + 1][i]; hv[i] = g * __builtin_amdgcn_rcpf(1.f + fexp(-g)) * u; }
        *(uint2*)(e.obf + row * DFF + j) = (uint2){pack2(hv[0], hv[1]), pack2(hv[2], hv[3])};
      }
    } else if (EPI == 1) {
      const int cb = n0 + wn * 64, spos = (int)(row & (size_t)(S_ - 1));
      const bool rd = cb < 512, rn = (cb >= C_NQ && cb < C_NKC + 64) || cb == C_NKS || cb == C_NKW;
      if (rd) {
        const f32x4 cs = *(const f32x4*)(e.rope + spos * 16 + 4 * quad), sn = *(const f32x4*)(e.rope + S_ * 16 + spos * 16 + 4 * quad);
#pragma unroll
        for (int g = 0; g < 2; ++g) { const f32x4 t1 = acc[mt][2 * g], t2 = acc[mt][2 * g + 1]; acc[mt][2 * g] = t1 * cs - t2 * sn; acc[mt][2 * g + 1] = t2 * cs + t1 * sn; }
      } else if (rn) {
#pragma unroll
        for (int g = 0; g < 2; ++g) {
          const f32x4 cs = *(const f32x4*)(e.rope + S_ * 32 + spos * 32 + g * 16 + 4 * quad), sn = *(const f32x4*)(e.rope + S_ * 64 + spos * 32 + g * 16 + 4 * quad);
          const f32x4 t1 = acc[mt][g], t2 = acc[mt][g + 2]; acc[mt][g] = t1 * cs - t2 * sn; acc[mt][g + 2] = t2 * cs + t1 * sn; }
      }
#pragma unroll
      for (int nt = 0; nt < 4; ++nt) { const int col = n0 + wn * 64 + nt * 16 + 4 * quad;
        *(uint2*)(e.obf + row * LDP + col) = (uint2){pack2(acc[mt][nt][0], acc[mt][nt][1]), pack2(acc[mt][nt][2], acc[mt][nt][3])}; }
    } else {
      float4 rv[4];
#pragma unroll
      for (int nt = 0; nt < 4; ++nt) rv[nt] = *(const float4*)(e.resid + row * D_ + n0 + wn * 64 + nt * 16 + 4 * quad);
#pragma unroll
      for (int nt = 0; nt < 4; ++nt) { const f32x4 a = acc[mt][nt];
        *(float4*)(e.of32 + row * D_ + n0 + wn * 64 + nt * 16 + 4 * quad) = (float4){e.alpha * rv[nt].x + e.sc * a[0], e.alpha * rv[nt].y + e.sc * a[1], e.alpha * rv[nt].z + e.sc * a[2], e.alpha * rv[nt].w + e.sc * a[3]}; }
    }
  }
#pragma unroll
  for (int i = 0; i < 4; ++i)
#pragma unroll
    for (int j = 0; j < 4; ++j) acc[i][j] = (f32x4){0.f, 0.f, 0.f, 0.f};
}
DI void gemm_compute(const bf16_t* sb, int wm, int wn, int l15, int quad, f32x4 (&acc)[4][4]) {
#pragma unroll
  for (int ks = 0; ks < 2; ++ks) {
    bf16x8 af[4], bfr[4];
#pragma unroll
    for (int mt = 0; mt < 4; ++mt) af[mt] = *(const bf16x8*)(sb + ((ks * 4 + quad) * 128 + wm * 64 + mt * 16 + (l15 & 8) + ((l15 + ks * 4 + quad) & 7)) * 8);
#pragma unroll
    for (int nt = 0; nt < 4; ++nt) bfr[nt] = *(const bf16x8*)(sb + 8192 + ((ks * 4 + quad) * 128 + wn * 64 + nt * 16 + (l15 & 8) + ((l15 + ks * 4 + quad) & 7)) * 8);
#pragma unroll
    for (int mt = 0; mt < 4; ++mt)
#pragma unroll
      for (int nt = 0; nt < 4; ++nt) acc[mt][nt] = MFMA16(af[mt], bfr[nt], acc[mt][nt]);
  }
}
DI void gemm_compute_sw(const bf16_t* sb, int wm, int wn, int l15, int quad, f32x4 (&acc)[4][4]) {
#pragma unroll
  for (int ks = 0; ks < 2; ++ks) {
    bf16x8 af[4], bfr[4];
    const int sl = ((ks * 4 + quad) ^ ((l15 >> 1) & 7)) * 8;
#pragma unroll
    for (int mt = 0; mt < 4; ++mt) af[mt] = *(const bf16x8*)(sb + (wm * 64 + mt * 16 + l15) * 64 + sl);
#pragma unroll
    for (int nt = 0; nt < 4; ++nt) bfr[nt] = *(const bf16x8*)(sb + 8192 + (wn * 64 + nt * 16 + l15) * 64 + sl);
#pragma unroll
    for (int mt = 0; mt < 4; ++mt)
#pragma unroll
      for (int nt = 0; nt < 4; ++nt) acc[mt][nt] = MFMA16(bfr[nt], af[mt], acc[mt][nt]);
  }
}
template <int EPI>
DI void gemm_phase(const bf16_t* __restrict__ A, int lda, const bf16_t* __restrict__ Bt, int K, int N, char* smem, const EpiArgs& e) {
  const int NT = N >> 7, ntiles = 128 * NT, nk = K >> 6;
  if ((int)blockIdx.x >= ntiles) return;
  const int cnt = (ntiles - (int)blockIdx.x + (int)gridDim.x - 1) / (int)gridDim.x, total = cnt * nk;
  const int tid = tid_(), lane = tid & 63, wave = __builtin_amdgcn_readfirstlane(tid >> 6), wm = wave >> 1, wn = wave & 1, l15 = lane & 15, quad = lane >> 4;
  bf16_t* sm = (bf16_t*)smem;
  const int lr = wave * 8 + (lane >> 3), lch = (lane & 7) ^ ((lr >> 1) & 7);
#define TILE_MN(tile_, m0_, n0_) { const int x_ = (tile_) & 7, u_ = (tile_) >> 3; m0_ = (x_ * 16 + (u_ & 15)) * 128; n0_ = (u_ >> 4) * 128; }
  int ltile = blockIdx.x, lk = 0, lg = 0; const bf16_t *Ag, *Bg;
  { int m0, n0; TILE_MN(ltile, m0, n0); Ag = A + (size_t)(m0 + lr) * lda + lch * 8; Bg = Bt + (size_t)(n0 + lr) * K + lch * 8; }
#define G_ISSUE(buf_) { bf16_t* sw = sm + (buf_) * 16384 + wave * 512; \
    _Pragma("unroll") for (int q = 0; q < 4; ++q) { \
      __builtin_amdgcn_global_load_lds((const unsigned*)(Ag + (size_t)(32 * q) * lda + lk * 64), (unsigned*)(sw + q * 2048), 16, 0, 0); \
      __builtin_amdgcn_global_load_lds((const unsigned*)(Bg + (size_t)(32 * q) * K + lk * 64), (unsigned*)(sw + 8192 + q * 2048), 16, 0, 0); } \
    if (lg + 1 < total) { ++lg; if (++lk == nk) { lk = 0; ltile += gridDim.x; int m0, n0; TILE_MN(ltile, m0, n0); Ag = A + (size_t)(m0 + lr) * lda + lch * 8; Bg = Bt + (size_t)(n0 + lr) * K + lch * 8; } } }
  f32x4 acc[4][4];
#pragma unroll
  for (int i = 0; i < 4; ++i)
#pragma unroll
    for (int j = 0; j < 4; ++j) acc[i][j] = (f32x4){0.f, 0.f, 0.f, 0.f};
  __syncthreads();
  G_ISSUE(0);
  vm_wait0();
  __syncthreads();
  int ctile = blockIdx.x, ck = 0;
  for (int g = 0; g < total; g += 2) {
    G_ISSUE(1);
    gemm_compute_sw(sm, wm, wn, l15, quad, acc);
    vm_wait0();
    __syncthreads();
    G_ISSUE(0);
    gemm_compute_sw(sm + 16384, wm, wn, l15, quad, acc);
    vm_wait0();
    __syncthreads();
    ck += 2;
    if (ck == nk) { int m0, n0; TILE_MN(ctile, m0, n0); gemm_epilogue<EPI>(acc, m0, n0, wm, wn, l15, quad, e); ck = 0; ctile += gridDim.x; }
  }
#undef G_ISSUE
#undef TILE_MN
}

DI void ln_phase(float* x32, bf16_t* xb, const float* g, const float* b) {
  const int lane = tid_() & 63, wv = tid_() >> 6;
  float4 gg[4], bb[4];
#pragma unroll
  for (int j = 0; j < 4; ++j) { gg[j] = *(const float4*)(g + j * 256 + lane * 4); bb[j] = *(const float4*)(b + j * 256 + lane * 4); }
  for (int row = blockIdx.x * 4 + wv; row < T_; row += gridDim.x * 4) {
    f32x4 v[4];
#pragma unroll
    for (int j = 0; j < 4; ++j) v[j] = gldfv(x32 + (size_t)row * D_ + j * 256 + lane * 4);
    asm volatile("s_waitcnt vmcnt(0)" : "+v"(v[0]), "+v"(v[1]), "+v"(v[2]), "+v"(v[3]) :: "memory");
    float s = 0.f;
#pragma unroll
    for (int j = 0; j < 4; ++j) s += (v[j][0] + v[j][1]) + (v[j][2] + v[j][3]);
    s = wave_sum(s); const float mu = s * (1.f / D_); float q = 0.f;
#pragma unroll
    for (int j = 0; j < 4; ++j) { v[j] -= mu; q += v[j][0] * v[j][0] + v[j][1] * v[j][1] + v[j][2] * v[j][2] + v[j][3] * v[j][3]; }
    q = wave_sum(q); const float rs = rsqrtf(q * (1.f / D_) + 1e-5f);
#pragma unroll
    for (int j = 0; j < 4; ++j) {
      const int c = j * 256 + lane * 4;
      float4 y; y.x = v[j][0] * rs * gg[j].x + bb[j].x; y.y = v[j][1] * rs * gg[j].y + bb[j].y; y.z = v[j][2] * rs * gg[j].z + bb[j].z; y.w = v[j][3] * rs * gg[j].w + bb[j].w;
      *(float4*)(x32 + (size_t)row * D_ + c) = y;
      uint2 pk; pk.x = pack2(y.x, y.y); pk.y = pack2(y.z, y.w); *(uint2*)(xb + (size_t)row * D_ + c) = pk;
    }
  }
}

DI void sincos_d(double r, double& sn, double& cs) {
  const double r2 = r * r; double a = 1.0, c = 1.0;
#pragma unroll
  for (int k = 14; k >= 1; --k) { a = 1.0 - r2 / (double)((2 * k) * (2 * k + 1)) * a; c = 1.0 - r2 / (double)((2 * k - 1) * (2 * k)) * c; }
  sn = r * a; cs = c;
}
DI void prologue_phase(const Params& p) {
  const size_t gt = (size_t)blockIdx.x * 256 + tid_(), gs = (size_t)gridDim.x * 256;
  float* rope = (float*)(p.ws + OFF_ROPE);
  for (size_t idx = gt; idx < (size_t)S_ * 48; idx += gs) {
    const int s = (int)(idx / 48), i = (int)(idx % 48); const int dim = i < 16 ? 32 : 64, fi = i < 16 ? i : i - 16;
    const float inv = powf(10000.f, -((float)(2 * fi) / (float)dim));
    const float ang = (float)s * inv;
    const double a = (double)ang, n = rint(a * 0.15915494309189535), r = a - n * 6.283185307179586;
    double sn, cs; sincos_d(r, sn, cs);
    if (i < 16) { rope[s * 16 + fi] = (float)cs; rope[S_ * 16 + s * 16 + fi] = (float)sn; }
    else { rope[S_ * 32 + s * 32 + fi] = (float)cs; rope[S_ * 64 + s * 32 + fi] = (float)sn; }
  }
  bf16_t* xb = (bf16_t*)(p.ws + OFF_XB);
  for (size_t i4 = gt; i4 < (size_t)T_ * D_ / 4; i4 += gs) {
    const float4 v = ((const float4*)p.x)[i4]; uint2 pk; pk.x = pack2(v.x, v.y); pk.y = pack2(v.z, v.w); ((uint2*)xb)[i4] = pk;
  }
}

DI void rope_phase(const Params& p) {
  bf16_t* proj = (bf16_t*)(p.ws + OFF_BIG); const float* rope = (const float*)(p.ws + OFF_ROPE);
  const size_t gt = (size_t)blockIdx.x * 256 + tid_(), gs = (size_t)gridDim.x * 256;
  for (size_t idx = gt; idx < (size_t)T_ * 60; idx += gs) {
    const int tok = (int)(idx / 60), u = (int)(idx % 60), s = tok & (S_ - 1);
    int c1, half; const float *cp, *sp;
    if (u < 32) { const int g = u >> 1, i0 = (u & 1) * 8; c1 = g * 32 + i0; half = 16; cp = rope + s * 16 + i0; sp = rope + S_ * 16 + s * 16 + i0; }
    else { const int q = u - 32, g = q >> 2, i0 = (q & 3) * 8;
      const int base = g < 4 ? C_NQ + g * 64 : (g == 4 ? C_NKC : (g == 5 ? C_NKS : C_NKW));
      c1 = base + i0; half = 32; cp = rope + S_ * 32 + s * 32 + i0; sp = rope + S_ * 64 + s * 32 + i0; }
    bf16_t* row = proj + (size_t)tok * LDP + c1;
    u32x4 a = gldv(row), bq = gldv(row + half); f32x4 c0 = gldfv(cp), c4 = gldfv(cp + 4), s0 = gldfv(sp), s4 = gldfv(sp + 4);
    asm volatile("s_waitcnt vmcnt(0)" : "+v"(a), "+v"(bq), "+v"(c0), "+v"(c4), "+v"(s0), "+v"(s4) :: "memory");
    u32x4 oa, ob;
#pragma unroll
    for (int w = 0; w < 4; ++w) {
      const float t1a = __uint_as_float(a[w] << 16), t1b = __uint_as_float(a[w] & 0xffff0000u), t2a = __uint_as_float(bq[w] << 16), t2b = __uint_as_float(bq[w] & 0xffff0000u);
      const float ca = w < 2 ? c0[2 * w] : c4[2 * w - 4], cb = w < 2 ? c0[2 * w + 1] : c4[2 * w - 3], sa = w < 2 ? s0[2 * w] : s4[2 * w - 4], sb = w < 2 ? s0[2 * w + 1] : s4[2 * w - 3];
      oa[w] = pack2(t1a * ca - t2a * sa, t1b * cb - t2b * sb); ob[w] = pack2(t2a * ca + t1a * sa, t2b * cb + t1b * sb);
    }
    *(u32x4*)row = oa; *(u32x4*)(row + half) = ob;
  }
}
DI void vt_tile(const Params& p, int item, char* smem) {
  const bf16_t* proj = (const bf16_t*)(p.ws + OFF_BIG); bf16_t* vt = (bf16_t*)(p.ws + OFF_VT);
  const int slot = item >> 8, t0 = (item & 255) * 64, tid = tid_();
  const int col = slot < 4 ? C_DV + slot * 64 : (slot < 8 ? C_SV + (slot - 4) * 64 : (slot == 8 ? C_NVW : C_NVS));
  bf16_t* tl = (bf16_t*)smem;
  __syncthreads();
#pragma unroll
  for (int i = 0; i < 2; ++i) { const int idx = tid + 256 * i, tk = idx >> 3, c = idx & 7;
    const uint4 v = *(const uint4*)(proj + (size_t)(t0 + tk) * LDP + col + c * 8);
    unsigned* d = (unsigned*)(tl + tk * 66 + c * 8); d[0] = v.x; d[1] = v.y; d[2] = v.z; d[3] = v.w; }
  __syncthreads();
#pragma unroll
  for (int i = 0; i < 8; ++i) { const int idx = tid + 256 * i, dv = idx >> 5, t2 = (idx & 31) * 2;
    const unsigned v = (unsigned)tl[t2 * 66 + dv] | ((unsigned)tl[(t2 + 1) * 66 + dv] << 16);
    *(unsigned*)(vt + (size_t)(slot * 64 + dv) * VLD + t0 + t2) = v; }
}
DI void gdn_conv(const Params& p, int l, int b, int hh, int s0, int which, float* dst, int ld, bool norm, float scale) {
  const bf16_t* proj = (const bf16_t*)(p.ws + OFF_BIG);
  const int tid = tid_(), c = tid >> 2, part = tid & 3;
  const int colbase = (which == 0 ? C_GQ : (which == 1 ? C_GK : C_GV)) + hh * 64 + part * 16, wch = which * 256 + hh * 64 + part * 16;
  u32x4 xv[8]; f32x4 wv[16];
#pragma unroll
  for (int j = 0; j < 4; ++j) {
    int sj = s0 + c - 3 + j; if (sj < 0) sj = 0;
    const bf16_t* xr = proj + (size_t)(b * S_ + sj) * LDP + colbase;
    xv[2 * j] = gldv(xr); xv[2 * j + 1] = gldv(xr + 8);
    const float* wr = p.convw + (size_t)(l * 4 + j) * 768 + wch;
#pragma unroll
    for (int q = 0; q < 4; ++q) wv[4 * j + q] = gldfv(wr + 4 * q);
  }
  asm volatile("s_waitcnt vmcnt(0)" : "+v"(xv[0]), "+v"(xv[1]), "+v"(xv[2]), "+v"(xv[3]), "+v"(xv[4]), "+v"(xv[5]), "+v"(xv[6]), "+v"(xv[7]),
               "+v"(wv[0]), "+v"(wv[1]), "+v"(wv[2]), "+v"(wv[3]), "+v"(wv[4]), "+v"(wv[5]), "+v"(wv[6]), "+v"(wv[7]),
               "+v"(wv[8]), "+v"(wv[9]), "+v"(wv[10]), "+v"(wv[11]), "+v"(wv[12]), "+v"(wv[13]), "+v"(wv[14]), "+v"(wv[15]) :: "memory");
  float acc[16];
#pragma unroll
  for (int d = 0; d < 16; ++d) acc[d] = 0.f;
#pragma unroll
  for (int j = 0; j < 4; ++j) {
    const float msk = (s0 + c - 3 + j >= 0) ? 1.f : 0.f;
#pragma unroll
    for (int q = 0; q < 4; ++q) {
      const unsigned x0 = xv[2 * j + (q >> 1)][(q & 1) * 2], x1 = xv[2 * j + (q >> 1)][(q & 1) * 2 + 1]; const f32x4 w = wv[4 * j + q];
      acc[4 * q] += msk * w[0] * __uint_as_float(x0 << 16); acc[4 * q + 1] += msk * w[1] * __uint_as_float(x0 & 0xffff0000u);
      acc[4 * q + 2] += msk * w[2] * __uint_as_float(x1 << 16); acc[4 * q + 3] += msk * w[3] * __uint_as_float(x1 & 0xffff0000u);
    }
  }
  float ss = 0.f;
#pragma unroll
  for (int d = 0; d < 16; ++d) { acc[d] = acc[d] / (1.f + __expf(-acc[d])); ss += acc[d] * acc[d]; }
  if (norm) { ss += __shfl_xor(ss, 1); ss += __shfl_xor(ss, 2); const float rn = rsqrtf(ss + 1e-6f) * scale;
#pragma unroll
    for (int d = 0; d < 16; ++d) acc[d] *= rn; }
#pragma unroll
  for (int d = 0; d < 16; ++d) dst[c * ld + part * 16 + d] = acc[d];
}
DI float softplus_f(float x) { return x > 20.f ? x : log1pf(expf(x)); }
DI void gdn_gates(const Params& p, int l, int b, int hh, int s0, float* sG, float* sBeta) {
  const bf16_t* proj = (const bf16_t*)(p.ws + OFF_BIG); const int tid = tid_();
  if (tid < 64) { const bf16_t* row = proj + (size_t)(b * S_ + s0 + tid) * LDP;
    const float a = bf2f(row[C_GA + hh]), bb = bf2f(row[C_GB + hh]);
    sG[tid] = -expf(p.alog[l * 4 + hh]) * softplus_f(a + p.dtb[l * 4 + hh]); sBeta[tid] = 1.f / (1.f + expf(-bb)); }
  __syncthreads();
  if (tid < 64) { float v = sG[tid];
#pragma unroll
    for (int o = 1; o < 64; o <<= 1) { const float u = __shfl_up(v, o); if (tid >= o) v += u; }
    sG[tid] = v; }
  __syncthreads();
}
DI void gdn_g1(const Params& p, int l, int ch, char* smem) {
  const int b = ch >> 9, hh = (ch >> 7) & 3, n = ch & 127, s0 = n * 64, tid = tid_(), c = tid >> 2, part = tid & 3;
  float* sA = (float*)smem; float* sR = sA + 4096; float* sG = sR + 64 * 129; float* sBeta = sG + 64;
  float* U = (float*)(p.ws + OFF_GU_) + (size_t)ch * 4096; float* W = (float*)(p.ws + OFF_GW) + (size_t)ch * 4096; float* KD = (float*)(p.ws + OFF_GKD) + (size_t)ch * 4096;
  __syncthreads();
  gdn_gates(p, l, b, hh, s0, sG, sBeta);
  gdn_conv(p, l, b, hh, s0, 1, sR + 64, 129, true, 1.f);
  gdn_conv(p, l, b, hh, s0, 2, sR, 129, false, 1.f);
  __syncthreads();
  const float Glast = sG[63], Gc = sG[c], bc = sBeta[c];
  { const float f = expf(Glast - Gc);
#pragma unroll
    for (int d = 0; d < 16; ++d) KD[c * 64 + part * 16 + d] = sR[c * 129 + 64 + part * 16 + d] * f; }
  for (int i = 0; i < 16; ++i) { const int s = part + 4 * i; float a = 0.f;
    if (s < c) { float dot = 0.f;
#pragma unroll 16
      for (int d = 0; d < 64; ++d) dot += sR[c * 129 + 64 + d] * sR[s * 129 + 64 + d];
      a = bc * dot * expf(Gc - sG[s]); }
    sA[c * 64 + s] = a; }
  __syncthreads();
  { const float f2 = bc * expf(Gc);
#pragma unroll
    for (int d = 0; d < 16; ++d) { sR[c * 129 + part * 16 + d] *= bc; sR[c * 129 + 64 + part * 16 + d] *= f2; } }
  __syncthreads();
  if (tid < 128) {
    float sol[64];
#pragma unroll
    for (int cc = 0; cc < 64; ++cc) sol[cc] = sR[cc * 129 + tid];
#pragma unroll
    for (int cc = 1; cc < 64; ++cc) { float a0 = 0.f, a1 = 0.f;
#pragma unroll
      for (int s2 = 0; s2 < cc; ++s2) { if (s2 & 1) a1 += sA[cc * 64 + s2] * sol[s2]; else a0 += sA[cc * 64 + s2] * sol[s2]; }
      sol[cc] -= a0 + a1; }
#pragma unroll
    for (int cc = 1; cc < 64; ++cc) sR[cc * 129 + tid] = sol[cc];
  }
  __syncthreads();
#pragma unroll
  for (int d = 0; d < 16; ++d) { U[c * 64 + part * 16 + d] = sR[c * 129 + part * 16 + d]; W[c * 64 + part * 16 + d] = sR[c * 129 + 64 + part * 16 + d]; }
  if (tid == 0) ((float*)(p.ws + OFF_GLAST))[ch] = expf(Glast);
}
DI void m0_phase(const Params& p, int l, char* smem) {
  if (blockIdx.x == 0 && tid_() < 64) ((unsigned*)(p.ws + OFF_CNT))[tid_()] = 0u;
  for (int it = blockIdx.x; it < 2560 + 1024; it += gridDim.x) {
    if (it < 1024) gdn_g1(p, l, it, smem); else vt_tile(p, it - 1024, smem);
  }
}

struct KVRegs { u32x4 k[2], v[2]; };
DI void kv_wait(KVRegs& rg) { asm volatile("s_waitcnt vmcnt(0)" : "+v"(rg.k[0]), "+v"(rg.k[1]), "+v"(rg.v[0]), "+v"(rg.v[1]) :: "memory"); }
template <int DQK> DI void kv_issue(const bf16_t* Kb, const bf16_t* Vt, int k0, KVRegs& rg) {
  const int tid = tid_();
  if (DQK == 64) {
#pragma unroll
    for (int q = 0; q < 2; ++q) { const int idx = tid + 256 * q, key = idx >> 3, c = idx & 7; rg.k[q] = gldv(Kb + (size_t)(k0 + key) * LDP + c * 8); }
  } else { const int key = tid >> 2, c = tid & 3; rg.k[0] = gldv(Kb + (size_t)(k0 + key) * LDP + c * 8); }
#pragma unroll
  for (int q = 0; q < 2; ++q) { const int idx = tid + 256 * q, dv = idx >> 3, c = idx & 7; rg.v[q] = gldv(Vt + (size_t)dv * VLD + k0 + c * 8); }
}
template <int DQK> DI void kv_commit(const KVRegs& rg, bf16_t* sK, bf16_t* sV) {
  constexpr int LDK = DQK + 8; const int tid = tid_();
  if (DQK == 64) {
#pragma unroll
    for (int q = 0; q < 2; ++q) { const int idx = tid + 256 * q, key = idx >> 3, c = idx & 7; *(u32x4*)(sK + key * LDK + c * 8) = rg.k[q]; }
  } else { const int key = tid >> 2, c = tid & 3; *(u32x4*)(sK + key * LDK + c * 8) = rg.k[0]; }
#pragma unroll
  for (int q = 0; q < 2; ++q) { const int idx = tid + 256 * q, dv = idx >> 3, c = idx & 7; const u32x4 v = rg.v[q];
    uint2* d = (uint2*)(sV + dv * 68 + c * 8); d[0] = (uint2){v[0], v[1]}; d[1] = (uint2){v[2], v[3]}; }
}
DI bf16x8 pack8(const f32x16& x, int s) {
  bf16x8 r;
#pragma unroll
  for (int j = 0; j < 8; ++j) r[j] = (short)f2bf(x[8 * s + j]);
  return r;
}
DI void pv_accum(const f32x16 (&s)[2], const bf16_t* sV, int r, int h, f32x16 (&O)[2]) {
#pragma unroll
  for (int t2 = 0; t2 < 2; ++t2)
#pragma unroll
    for (int s2 = 0; s2 < 2; ++s2) {
      const bf16x8 pf = pack8(s[t2], s2);
#pragma unroll
      for (int dt = 0; dt < 2; ++dt) {
        const bf16_t* vp = sV + (dt * 32 + r) * 68 + t2 * 32 + 16 * s2 + 4 * h;
        const s16x4 lo = *(const s16x4*)vp, hi = *(const s16x4*)(vp + 8);
        const bf16x8 vf = __builtin_shufflevector(lo, hi, 0, 1, 2, 3, 4, 5, 6, 7);
        O[dt] = MFMA32(vf, pf, O[dt]);
      }
    }
}
template <int DQK>
DI void attn_tile_step(const bf16_t* sK, const bf16_t* sV, const bf16x8 (&qf)[DQK / 16], int k0, int qpos, int window, float sl2, float& m, float& lsum, f32x16 (&O)[2], int r, int h) {
  constexpr int NKS = DQK / 16, LDK = DQK + 8;
  f32x16 s[2];
#pragma unroll
  for (int t2 = 0; t2 < 2; ++t2) {
#pragma unroll
    for (int i = 0; i < 16; ++i) s[t2][i] = 0.f;
#pragma unroll
    for (int ks = 0; ks < NKS; ++ks) { const bf16x8 a = *(const bf16x8*)(sK + (t2 * 32 + r) * LDK + ks * 16 + 8 * h); s[t2] = MFMA32(a, qf[ks], s[t2]); }
  }
  float mx = m;
#pragma unroll
  for (int t2 = 0; t2 < 2; ++t2)
#pragma unroll
    for (int i = 0; i < 16; ++i) { const int kpos = k0 + t2 * 32 + crow(i, h); const bool ok = (kpos <= qpos) && (window == 0 || qpos - kpos < window);
      const float v = ok ? s[t2][i] * sl2 : -1e30f; s[t2][i] = v; mx = fmaxf(mx, v); }
  mx = fmaxf(mx, __shfl_xor(mx, 32));
  const float corr = fexp2(m - mx); m = mx; float ps = 0.f;
#pragma unroll
  for (int t2 = 0; t2 < 2; ++t2)
#pragma unroll
    for (int i = 0; i < 16; ++i) { const float pv = (s[t2][i] > -1e29f) ? fexp2(s[t2][i] - mx) : 0.f; s[t2][i] = pv; ps += pv; }
  lsum = lsum * corr + ps;
#pragma unroll
  for (int dt = 0; dt < 2; ++dt)
#pragma unroll
    for (int i = 0; i < 16; ++i) O[dt][i] *= corr;
  pv_accum(s, sV, r, h, O);
}
DI void o_zero(f32x16 (&O)[2]) {
#pragma unroll
  for (int dt = 0; dt < 2; ++dt)
#pragma unroll
    for (int i = 0; i < 16; ++i) O[dt][i] = 0.f;
}
DI void o_finish(f32x16 (&O)[2], float lsum) {
  lsum += __shfl_xor(lsum, 32);
  const float inv = 1.f / lsum;
#pragma unroll
  for (int dt = 0; dt < 2; ++dt)
#pragma unroll
    for (int i = 0; i < 16; ++i) O[dt][i] *= inv;
}
DI void store_o(const f32x16 (&O)[2], bf16_t* dst  , int h) {
#pragma unroll
  for (int dt = 0; dt < 2; ++dt)
#pragma unroll
    for (int g = 0; g < 4; ++g) { uint2 pk; pk.x = pack2(O[dt][4 * g], O[dt][4 * g + 1]); pk.y = pack2(O[dt][4 * g + 2], O[dt][4 * g + 3]); *(uint2*)(dst + dt * 32 + 8 * g + 4 * h) = pk; }
}
DI void diff_item(const Params& p, int l, int b, int hh, int qb, char* smem) {
  const bf16_t* proj = (const bf16_t*)(p.ws + OFF_BIG) + (size_t)(b * S_) * LDP;
  const bf16_t* vt = (const bf16_t*)(p.ws + OFF_VT) + (size_t)(hh * 64) * VLD + b * S_;
  const int q0 = qb * 128, tid = tid_(), lane = tid & 63, wave = tid >> 6, r = lane & 31, h = lane >> 5, qw0 = q0 + wave * 32, qpos = qw0 + r;
  bf16_t* sK1 = (bf16_t*)smem; bf16_t* sK2 = sK1 + 64 * 40; bf16_t* sV = sK2 + 64 * 40;
  float d1 = 0.f, d2 = 0.f;
  for (int i = 0; i < 32; ++i) { d1 += p.lq1[l * 32 + i] * p.lk1[l * 32 + i]; d2 += p.lq2[l * 32 + i] * p.lk2[l * 32 + i]; }
  asm volatile("" : "+v"(d1), "+v"(d2));
  const float lam_init = 0.8f - 0.6f * expf(-0.3f * (float)l), lam = expf(d1) - expf(d2) + lam_init;
  const float sl2 = 0.17677669529663687f * 1.4426950408889634f;
  bf16x8 qf1[2], qf2[2];
#pragma unroll
  for (int ks = 0; ks < 2; ++ks) { qf1[ks] = *(const bf16x8*)(proj + (size_t)qpos * LDP + C_DQ1 + hh * 32 + ks * 16 + 8 * h); qf2[ks] = *(const bf16x8*)(proj + (size_t)qpos * LDP + C_DQ2 + hh * 32 + ks * 16 + 8 * h); }
  f32x16 O1[2], O2[2]; o_zero(O1); o_zero(O2);
  float m1 = -1e30f, m2 = -1e30f, l1 = 0.f, l2 = 0.f;
  const int kt1 = (q0 + 128) >> 6;
  const bf16_t* K1g = proj + C_DK1 + hh * 32; const bf16_t* K2g = proj + C_DK2 + hh * 32;
  KVRegs rg; rg.k[1] = (u32x4){0u, 0u, 0u, 0u}; uint4 rk2;
  kv_issue<32>(K1g, vt, 0, rg); rk2 = gld16(K2g + (size_t)(tid >> 2) * LDP + (tid & 3) * 8);
#pragma unroll 1
  for (int kt = 0; kt < kt1; ++kt) {
    const int k0 = kt * 64;
    kv_wait(rg); vm_wait0();
    __syncthreads();
    kv_commit<32>(rg, sK1, sV); *(uint4*)(sK2 + (tid >> 2) * 40 + (tid & 3) * 8) = rk2;
    __syncthreads();
    { const int kn = (kt + 1 < kt1 ? kt + 1 : kt) * 64; kv_issue<32>(K1g, vt, kn, rg); rk2 = gld16(K2g + (size_t)(kn + (tid >> 2)) * LDP + (tid & 3) * 8); }
    if (k0 > qw0 + 31) continue;
    attn_tile_step<32>(sK1, sV, qf1, k0, qpos, 0, sl2, m1, l1, O1, r, h);
    __builtin_amdgcn_sched_barrier(0);
    attn_tile_step<32>(sK2, sV, qf2, k0, qpos, 0, sl2, m2, l2, O2, r, h);
    __builtin_amdgcn_sched_barrier(0);
  }
  vm_wait0();
  o_finish(O1, l1); o_finish(O2, l2);
  float ss = 0.f;
#pragma unroll
  for (int dt = 0; dt < 2; ++dt)
#pragma unroll
    for (int i = 0; i < 16; ++i) { const float o = O1[dt][i] - lam * O2[dt][i]; O1[dt][i] = o; ss += o * o; }
  ss += __shfl_xor(ss, 32);
  const float rn = rsqrtf(ss * (1.f / 64.f) + 1e-6f) * (1.f - lam_init);
  int goff = l * 64 + 4 * h; asm volatile("" : "+v"(goff));
#pragma unroll
  for (int dt = 0; dt < 2; ++dt)
#pragma unroll
    for (int g = 0; g < 4; ++g) { const float4 gg = *(const float4*)(p.subln + goff + dt * 32 + 8 * g);
      O1[dt][4 * g] *= rn * gg.x; O1[dt][4 * g + 1] *= rn * gg.y; O1[dt][4 * g + 2] *= rn * gg.z; O1[dt][4 * g + 3] *= rn * gg.w; }
  bf16_t* mix = (bf16_t*)(p.ws + OFF_XB);
  store_o(O1, mix + (size_t)(b * S_ + qpos) * D_ + hh * 64, h);
}
DI void win_item(const Params& p, int b, int hh, int qb, char* smem) {
  const bf16_t* proj = (const bf16_t*)(p.ws + OFF_BIG) + (size_t)(b * S_) * LDP;
  const bf16_t* vt = (const bf16_t*)(p.ws + OFF_VT) + (size_t)(8 * 64) * VLD + b * S_;
  const int q0 = qb * 128, lane = tid_() & 63, wave = tid_() >> 6, r = lane & 31, h = lane >> 5, qw0 = q0 + wave * 32, qpos = qw0 + r;
  bf16_t* sK = (bf16_t*)smem; bf16_t* sV = sK + 64 * 72;
  int kt0 = (q0 >> 6) - 8; if (kt0 < 0) kt0 = 0;
  bf16x8 qf[4];
#pragma unroll
  for (int ks = 0; ks < 4; ++ks) qf[ks] = *(const bf16x8*)(proj + (size_t)qpos * LDP + C_NQ + hh * 64 + ks * 16 + 8 * h);
  f32x16 O[2]; o_zero(O);
  float m = -1e30f, lsum = 0.f;
  const int kt1 = (q0 + 128) >> 6;
  KVRegs rg; kv_issue<64>(proj + C_NKW, vt, kt0 * 64, rg);
#pragma unroll 1
  for (int kt = kt0; kt < kt1; ++kt) {
    const int k0 = kt * 64;
    kv_wait(rg);
    __syncthreads();
    kv_commit<64>(rg, sK, sV);
    __syncthreads();
    kv_issue<64>(proj + C_NKW, vt, (kt + 1 < kt1 ? kt + 1 : kt) * 64, rg);
    if (k0 > qw0 + 31) continue;
    if (k0 + 63 < qw0 - 511) continue;
    attn_tile_step<64>(sK, sV, qf, k0, qpos, 512, 0.125f * 1.4426950408889634f, m, lsum, O, r, h);
  }
  vm_wait0();
  o_finish(O, lsum);
  bf16_t* ow = (bf16_t*)(p.ws + OFF_OWIN);
  store_o(O, ow + (size_t)(b * S_ + qpos) * 256 + hh * 64, h);
}
DI void sb_item(const Params& p, int b, int hh, int qb, char* smem) {
  const bf16_t* proj = (const bf16_t*)(p.ws + OFF_BIG) + (size_t)(b * S_) * LDP;
  const bf16_t* Qb = proj + C_SQ + hh * 64; const bf16_t* Kb = proj + C_SK + hh * 64;
  const bf16_t* Vt = (const bf16_t*)(p.ws + OFF_VT) + (size_t)((4 + hh) * 64) * VLD + b * S_;
  bf16_t* sK = (bf16_t*)smem; bf16_t* sV = sK + 64 * 72;
  const int q0 = qb * 128, lane = tid_() & 63, wave = tid_() >> 6, r = lane & 31, h = lane >> 5;
  const int qw0 = q0 + wave * 32, qpos = qw0 + r;
  bf16x8 qf[4];
#pragma unroll
  for (int ks = 0; ks < 4; ++ks) qf[ks] = *(const bf16x8*)(Qb + (size_t)qpos * LDP + ks * 16 + 8 * h);
  f32x16 O[2];
#pragma unroll
  for (int dt = 0; dt < 2; ++dt)
#pragma unroll
    for (int i = 0; i < 16; ++i) O[dt][i] = 0.f;
  float R = 0.f;
  float* sflag = (float*)(smem + 20480);
  if (tid_() < 4) sflag[tid_()] = 0.f;
  KVRegs rg; kv_issue<64>(Kb, Vt, ((q0 + 127) >> 6) * 64, rg);
#pragma unroll 1
  for (int kt = (q0 + 127) >> 6; kt >= 0; --kt) {
    const int k0 = kt * 64;
    kv_wait(rg);
    __syncthreads();
    const float rmin = fminf(fminf(sflag[0], sflag[1]), fminf(sflag[2], sflag[3]));
    if (rmin > 90.f) break;
    kv_commit<64>(rg, sK, sV);
    __syncthreads();
    kv_issue<64>(Kb, Vt, (kt > 0 ? kt - 1 : 0) * 64, rg);
    if (k0 >= qw0 + 31) continue;
    { const float wmin = -wave_max(-R); if (wmin > 90.f) continue; }
    f32x16 s[2];
#pragma unroll
    for (int t2 = 0; t2 < 2; ++t2) {
#pragma unroll
      for (int i = 0; i < 16; ++i) s[t2][i] = 0.f;
#pragma unroll
      for (int ks = 0; ks < 4; ++ks) { const bf16x8 a = *(const bf16x8*)(sK + (t2 * 32 + r) * 72 + ks * 16 + 8 * h); s[t2] = MFMA32(a, qf[ks], s[t2]); }
    }
    float Tt = 0.f;
#pragma unroll
    for (int t2 = 1; t2 >= 0; --t2)
#pragma unroll
      for (int g = 3; g >= 0; --g) {
        float z[4], sp[4]; bool ok[4]; float gs = 0.f;
#pragma unroll
        for (int e = 0; e < 4; ++e) { const int kpos = k0 + t2 * 32 + 8 * g + 4 * h + e; ok[e] = kpos < qpos; z[e] = s[t2][4 * g + e] * 0.125f;
          const float spv = fmaxf(z[e], 0.f) + flog(1.f + fexp(-fabsf(z[e]))); sp[e] = ok[e] ? spv : 0.f; gs += sp[e]; }
        const float pg = __shfl_xor(gs, 32);
        float run = R + Tt + (h == 0 ? pg : 0.f);
#pragma unroll
        for (int e = 3; e >= 0; --e) { run += sp[e]; s[t2][4 * g + e] = ok[e] ? fexp(z[e] - run) : 0.f; }
        Tt += gs + pg;
      }
    R += Tt;
    { const float wmin = -wave_max(-R); if (lane == 0) sflag[wave] = wmin; }
    pv_accum(s, sV, r, h, O);
  }
  vm_wait0();
  bf16_t* mix = (bf16_t*)(p.ws + OFF_XB);
  store_o(O, mix + (size_t)(b * S_ + qpos) * D_ + 768 + hh * 64, h);
}

DI void gdn_chain(const Params& p, int item, char* smem) {
  const int b = item >> 4, hh = (item >> 2) & 3, sl = item & 3, tid = tid_(), c = tid >> 2, e4 = (tid & 3) * 4;
  float* sW = (float*)smem; float* sKD = sW + 64 * 65; float* sS = sKD + 64 * 65; float* sV = sS + 1024; float* sU = sV + 1024;
  float* U = (float*)(p.ws + OFF_GU_); const float* W = (const float*)(p.ws + OFF_GW); const float* KD = (const float*)(p.ws + OFF_GKD);
  float* Sg = (float*)(p.ws + OFF_GS); const float* glast = (const float*)(p.ws + OFF_GLAST);
  const int ch0 = (b * 4 + hh) * 128;
  __syncthreads();
  *(float4*)(sS + tid * 4) = (float4){0.f, 0.f, 0.f, 0.f};
  float4 rw[4], rk[4], ru;
  { const float4* wp = (const float4*)(W + (size_t)ch0 * 4096); const float4* kp = (const float4*)(KD + (size_t)ch0 * 4096);
#pragma unroll
    for (int i = 0; i < 4; ++i) { rw[i] = gldf4(wp + tid + 256 * i); rk[i] = gldf4(kp + tid + 256 * i); }
    ru = gldf4(U + (size_t)ch0 * 4096 + c * 64 + sl * 16 + e4); }
  for (int n = 0; n < 128; ++n) {
    const int ch = ch0 + n;
    vm_wait0();
    __syncthreads();
#pragma unroll
    for (int i = 0; i < 4; ++i) { const int idx = (tid + 256 * i) * 4, rr = idx >> 6, cc = idx & 63;
      float* dw = sW + rr * 65 + cc; dw[0] = rw[i].x; dw[1] = rw[i].y; dw[2] = rw[i].z; dw[3] = rw[i].w;
      float* dk = sKD + rr * 65 + cc; dk[0] = rk[i].x; dk[1] = rk[i].y; dk[2] = rk[i].z; dk[3] = rk[i].w; }
    *(float4*)(sU + c * 16 + e4) = ru;
    const float gl = glast[ch];
    __syncthreads();
    if (n + 1 < 128) { const float4* wp = (const float4*)(W + (size_t)(ch + 1) * 4096); const float4* kp = (const float4*)(KD + (size_t)(ch + 1) * 4096);
#pragma unroll
      for (int i = 0; i < 4; ++i) { rw[i] = gldf4(wp + tid + 256 * i); rk[i] = gldf4(kp + tid + 256 * i); }
      ru = gldf4(U + (size_t)(ch + 1) * 4096 + c * 64 + sl * 16 + e4); }
    float4 acc = *(const float4*)(sU + c * 16 + e4);
#pragma unroll 8
    for (int d = 0; d < 64; ++d) { const float wv = sW[c * 65 + d]; const float4 sv = *(const float4*)(sS + d * 16 + e4);
      acc.x -= wv * sv.x; acc.y -= wv * sv.y; acc.z -= wv * sv.z; acc.w -= wv * sv.w; }
    *(float4*)(sV + c * 16 + e4) = acc;
    *(float4*)(U + (size_t)ch * 4096 + c * 64 + sl * 16 + e4) = acc;
    float4 sold = *(const float4*)(sS + c * 16 + e4);
    *(float4*)(Sg + (size_t)ch * 4096 + c * 64 + sl * 16 + e4) = sold;
    __syncthreads();
    sold.x *= gl; sold.y *= gl; sold.z *= gl; sold.w *= gl;
#pragma unroll 8
    for (int cc = 0; cc < 64; ++cc) { const float kv = sKD[cc * 65 + c]; const float4 vv = *(const float4*)(sV + cc * 16 + e4);
      sold.x += kv * vv.x; sold.y += kv * vv.y; sold.z += kv * vv.z; sold.w += kv * vv.w; }
    *(float4*)(sS + c * 16 + e4) = sold;
  }
}
DI void gdn_g3(const Params& p, int l, int ch, char* smem) {
  const int b = ch >> 9, hh = (ch >> 7) & 3, n = ch & 127, s0 = n * 64, tid = tid_(), c = tid >> 2, part = tid & 3;
  float* B1 = (float*)smem; float* B2 = B1 + 64 * 68; float* B3 = B2 + 64 * 68; float* sG = B3 + 64 * 68; float* sBeta = sG + 64;
  const float* Vn = (const float*)(p.ws + OFF_GU_) + (size_t)ch * 4096; const float* Sg = (const float*)(p.ws + OFF_GS) + (size_t)ch * 4096;
  __syncthreads();
  gdn_gates(p, l, b, hh, s0, sG, sBeta);
  gdn_conv(p, l, b, hh, s0, 0, B1, 68, true, 0.125f);
  gdn_conv(p, l, b, hh, s0, 1, B2, 68, true, 1.f);
  __syncthreads();
  const float Gc = sG[c];
  for (int i = 0; i < 16; ++i) { const int s = part + 4 * i; float a = 0.f;
    if (s <= c) { float dot = 0.f;
#pragma unroll
      for (int d4 = 0; d4 < 16; ++d4) { const float4 x = *(const float4*)(B1 + c * 68 + 4 * d4), y = *(const float4*)(B2 + s * 68 + 4 * d4); dot += (x.x * y.x + x.y * y.y) + (x.z * y.z + x.w * y.w); }
      a = dot * expf(Gc - sG[s]); }
    B3[c * 68 + s] = a; }
  __syncthreads();
#pragma unroll
  for (int i = 0; i < 4; ++i) { const int idx = (tid + 256 * i) * 4, rr = idx >> 6, cc = idx & 63; const float4 v = *(const float4*)(Sg + idx);
    *(float4*)(B2 + rr * 68 + cc) = v; }
  __syncthreads();
  float acc[16];
#pragma unroll
  for (int e = 0; e < 16; ++e) acc[e] = 0.f;
#pragma unroll 2
  for (int d4 = 0; d4 < 16; ++d4) { const float4 q4 = *(const float4*)(B1 + c * 68 + 4 * d4); const float qv[4] = {q4.x, q4.y, q4.z, q4.w};
#pragma unroll
    for (int dd = 0; dd < 4; ++dd)
#pragma unroll
      for (int e4 = 0; e4 < 4; ++e4) { const float4 bv = *(const float4*)(B2 + (4 * d4 + dd) * 68 + part * 16 + 4 * e4);
        acc[4 * e4] += qv[dd] * bv.x; acc[4 * e4 + 1] += qv[dd] * bv.y; acc[4 * e4 + 2] += qv[dd] * bv.z; acc[4 * e4 + 3] += qv[dd] * bv.w; } }
  { const float eg = expf(Gc);
#pragma unroll
    for (int e = 0; e < 16; ++e) acc[e] *= eg; }
  __syncthreads();
#pragma unroll
  for (int i = 0; i < 4; ++i) { const int idx = (tid + 256 * i) * 4, rr = idx >> 6, cc = idx & 63; const float4 v = *(const float4*)(Vn + idx);
    *(float4*)(B2 + rr * 68 + cc) = v; }
  __syncthreads();
#pragma unroll 2
  for (int s4 = 0; s4 < 16; ++s4) { const float4 i4 = *(const float4*)(B3 + c * 68 + 4 * s4); const float iv[4] = {i4.x, i4.y, i4.z, i4.w};
#pragma unroll
    for (int dd = 0; dd < 4; ++dd)
#pragma unroll
      for (int e4 = 0; e4 < 4; ++e4) { const float4 bv = *(const float4*)(B2 + (4 * s4 + dd) * 68 + part * 16 + 4 * e4);
        acc[4 * e4] += iv[dd] * bv.x; acc[4 * e4 + 1] += iv[dd] * bv.y; acc[4 * e4 + 2] += iv[dd] * bv.z; acc[4 * e4 + 3] += iv[dd] * bv.w; } }
  float ss = 0.f;
#pragma unroll
  for (int e = 0; e < 16; ++e) ss += acc[e] * acc[e];
  ss += __shfl_xor(ss, 1); ss += __shfl_xor(ss, 2);
  const float rn = rsqrtf(ss * (1.f / 64.f) + 1e-6f);
  const size_t tok = (size_t)(b * S_ + s0 + c);
  const bf16_t* zr = (const bf16_t*)(p.ws + OFF_BIG) + tok * LDP + C_GZ + hh * 64 + part * 16;
  bf16_t* mix = (bf16_t*)(p.ws + OFF_XB) + tok * D_ + 256 + hh * 64 + part * 16;
#pragma unroll
  for (int e = 0; e < 16; e += 2) {
    const float z0 = bf2f(zr[e]), z1 = bf2f(zr[e + 1]);
    const float y0 = acc[e] * rn * p.gdng[l * 64 + part * 16 + e] * (z0 / (1.f + __expf(-z0)));
    const float y1 = acc[e + 1] * rn * p.gdng[l * 64 + part * 16 + e + 1] * (z1 / (1.f + __expf(-z1)));
    *(unsigned*)(mix + e) = pack2(y0, y1);
  }
}

DI void nsa_compress(const Params& p, int l, int item, char* smem) {
  const int b = item >> 7, kv = (item >> 6) & 1, grp = item & 63, c0 = grp * 8, tok0 = c0 * 16, tid = tid_(), lane = tid & 63, wv = tid >> 6;
  const bf16_t* proj = (const bf16_t*)(p.ws + OFF_BIG) + (size_t)(b * S_) * LDP + (kv ? C_NVC : C_NKC);
  bf16_t* X = (bf16_t*)smem;
  float* Hp = (float*)(smem + 18432);
  __syncthreads();
  for (int idx = tid; idx < 144 * 8; idx += 256) { const int tk = idx >> 3, c = idx & 7, si = tok0 + tk;
    uint4 v = {0u, 0u, 0u, 0u}; if (si < S_) v = *(const uint4*)(proj + (size_t)si * LDP + c * 8);
    *(uint4*)(X + tk * 64 + c * 8) = v; }
  __syncthreads();
  const float* w1 = (kv ? p.cvw1 : p.ckw1) + (size_t)l * 2048 * 256 + lane * 4; const float* pe = (kv ? p.pev : p.pek) + (size_t)l * 2048;
  float acc[8][4], bias[4] = {0.f, 0.f, 0.f, 0.f};
#pragma unroll
  for (int r = 0; r < 8; ++r) { acc[r][0] = 0.f; acc[r][1] = 0.f; acc[r][2] = 0.f; acc[r][3] = 0.f; }
  const int i0 = wv * 512;
  for (int ib = 0; ib < 512; ib += 8) {
    f32x4 wr[8];
#pragma unroll
    for (int u = 0; u < 8; ++u) wr[u] = gldfv(w1 + (size_t)(i0 + ib + u) * 256);
    asm volatile("s_waitcnt vmcnt(0)" : "+v"(wr[0]), "+v"(wr[1]), "+v"(wr[2]), "+v"(wr[3]), "+v"(wr[4]), "+v"(wr[5]), "+v"(wr[6]), "+v"(wr[7]) :: "memory");
#pragma unroll
    for (int u = 0; u < 8; ++u) { const int i = i0 + ib + u, tk = i >> 6, d = i & 63; const float pv = pe[i]; const f32x4 w = wr[u];
      bias[0] += pv * w[0]; bias[1] += pv * w[1]; bias[2] += pv * w[2]; bias[3] += pv * w[3];
#pragma unroll
      for (int r = 0; r < 8; ++r) { const float xv = bf2f(X[(16 * r + tk) * 64 + d]); acc[r][0] += xv * w[0]; acc[r][1] += xv * w[1]; acc[r][2] += xv * w[2]; acc[r][3] += xv * w[3]; } }
  }
#pragma unroll
  for (int r = 0; r < 8; ++r) *(float4*)(Hp + (wv * 8 + r) * 256 + lane * 4) = (float4){acc[r][0] + bias[0], acc[r][1] + bias[1], acc[r][2] + bias[2], acc[r][3] + bias[3]};
  __syncthreads();
#pragma unroll
  for (int q = 0; q < 8; ++q) { const int idx = tid + 256 * q; const float hv = Hp[idx] + Hp[2048 + idx] + Hp[4096 + idx] + Hp[6144 + idx]; Hp[idx] = hv / (1.f + __expf(-hv)); }
  __syncthreads();
  const float* H = Hp;
  const float* w2 = (kv ? p.cvw2 : p.ckw2) + (size_t)l * 256 * 64;
  const int r0 = tid >> 6, d = tid & 63; float o0 = 0.f, o1 = 0.f;
  for (int jb = 0; jb < 256; jb += 16) { float w[16];
#pragma unroll
    for (int u = 0; u < 16; ++u) w[u] = gld32(w2 + (jb + u) * 64 + d);
    asm volatile("s_waitcnt vmcnt(0)" : "+v"(w[0]), "+v"(w[1]), "+v"(w[2]), "+v"(w[3]), "+v"(w[4]), "+v"(w[5]), "+v"(w[6]), "+v"(w[7]), "+v"(w[8]), "+v"(w[9]), "+v"(w[10]), "+v"(w[11]), "+v"(w[12]), "+v"(w[13]), "+v"(w[14]), "+v"(w[15]) :: "memory");
#pragma unroll
    for (int u = 0; u < 16; ++u) { o0 += H[r0 * 256 + jb + u] * w[u]; o1 += H[(r0 + 4) * 256 + jb + u] * w[u]; } }
  bf16_t* dst = (bf16_t*)(p.ws + (kv ? OFF_VCMP : OFF_KCMP)) + (size_t)b * (kv ? 64 * CLD : 512 * 64);
  { const int c1 = c0 + r0, c2 = c0 + r0 + 4; const float v1 = c1 < 511 ? o0 : 0.f, v2 = c2 < 511 ? o1 : 0.f;
    if (kv) { dst[d * CLD + c1] = f2bf(v1); dst[d * CLD + c2] = f2bf(v2); } else { dst[c1 * 64 + d] = f2bf(v1); dst[c2 * 64 + d] = f2bf(v2); } }
}
struct SelRegs { u32x4 ka[2], kb[2], v[4]; };
DI void sel_issue(SelRegs& rg, const bf16_t* kbase  , int kld, const bf16_t* vtbase  , int vld, int rowa, int l15, int quad) {
#pragma unroll
  for (int ks = 0; ks < 2; ++ks) { rg.ka[ks] = gldv(kbase + (size_t)rowa * kld + ks * 32 + quad * 8); rg.kb[ks] = gldv(kbase + (size_t)(rowa + 4) * kld + ks * 32 + quad * 8); }
#pragma unroll
  for (int dt = 0; dt < 4; ++dt) rg.v[dt] = gldv(vtbase + (size_t)(dt * 16 + l15) * vld + 8 * quad);
}
DI void sel_wait(SelRegs& rg) {
  asm volatile("s_waitcnt vmcnt(0)" : "+v"(rg.ka[0]), "+v"(rg.ka[1]), "+v"(rg.kb[0]), "+v"(rg.kb[1]), "+v"(rg.v[0]), "+v"(rg.v[1]), "+v"(rg.v[2]), "+v"(rg.v[3]) :: "memory");
}
DI void sel_compute(const SelRegs& rg, const bf16x8 (&qf)[2], int kb0, bool colsel, int stk, int quad, float& m, float& lsum, f32x4 (&Os)[4]) {
  f32x4 sa = {0.f, 0.f, 0.f, 0.f}, sb = {0.f, 0.f, 0.f, 0.f};
#pragma unroll
  for (int ks = 0; ks < 2; ++ks) { sa = MFMA16(__builtin_bit_cast(bf16x8, rg.ka[ks]), qf[ks], sa); sb = MFMA16(__builtin_bit_cast(bf16x8, rg.kb[ks]), qf[ks], sb); }
  float mx = m;
#pragma unroll
  for (int i = 0; i < 4; ++i) { const int ka = kb0 + 8 * quad + i;
    const float va = (colsel && ka <= stk) ? sa[i] * 0.125f : -1e30f, vb = (colsel && ka + 4 <= stk) ? sb[i] * 0.125f : -1e30f;
    sa[i] = va; sb[i] = vb; mx = fmaxf(mx, fmaxf(va, vb)); }
  mx = fmaxf(mx, __shfl_xor(mx, 16)); mx = fmaxf(mx, __shfl_xor(mx, 32));
  const float corr = fexp(m - mx); m = mx; float ps = 0.f;
#pragma unroll
  for (int i = 0; i < 4; ++i) { const float pa = sa[i] > -1e29f ? fexp(sa[i] - mx) : 0.f, pb = sb[i] > -1e29f ? fexp(sb[i] - mx) : 0.f; sa[i] = pa; sb[i] = pb; ps += pa + pb; }
  lsum = lsum * corr + ps;
  bf16x8 pf;
#pragma unroll
  for (int i = 0; i < 4; ++i) { pf[i] = (short)f2bf(sa[i]); pf[4 + i] = (short)f2bf(sb[i]); }
#pragma unroll
  for (int dt = 0; dt < 4; ++dt) { Os[dt][0] *= corr; Os[dt][1] *= corr; Os[dt][2] *= corr; Os[dt][3] *= corr; Os[dt] = MFMA16(__builtin_bit_cast(bf16x8, rg.v[dt]), pf, Os[dt]); }
}
DI void nsa_group(const Params& p, int t0, float* wl) {
  const int lane = tid_() & 63, l15 = lane & 15, quad = lane >> 4, tk = l15 >> 2, hd = l15 & 3;
  const int b = t0 >> 13, s0 = t0 & (S_ - 1), cur = s0 >> 6, stk = s0 + tk;
  const bf16_t* projb = (const bf16_t*)(p.ws + OFF_BIG) + (size_t)(b * S_) * LDP;
  const bf16_t* kc = (const bf16_t*)(p.ws + OFF_KCMP) + (size_t)b * 512 * 64; const bf16_t* vcT = (const bf16_t*)(p.ws + OFF_VCMP) + (size_t)b * 64 * CLD;
  const bf16_t* vsT = (const bf16_t*)(p.ws + OFF_VT) + (size_t)(9 * 64) * VLD + b * S_;
  float* Gs = wl; float* Cs = wl + 4 * 132; int* blist = (int*)(wl + 8 * 132);
  WAVE_SYNC();
  for (int i = lane; i < 8 * 132; i += 64) wl[i] = 0.f;
  bf16x8 qf[2];
#pragma unroll
  for (int ks = 0; ks < 2; ++ks) qf[ks] = *(const bf16x8*)(projb + (size_t)stk * LDP + C_NQ + hd * 64 + ks * 32 + quad * 8);
  const int ncv = stk >= 31 ? ((stk - 31) >> 4) + 1 : 0, ncvmax = (s0 + 3 >= 31) ? ((s0 + 3 - 31) >> 4) + 1 : 0, nstep = (ncvmax + 31) >> 5;
  const int rowa = (l15 >> 2) * 8 + (l15 & 3);
  float m = -1e30f, lsum = 0.f;
  SelRegs c0r, c1r;
  f32x4 Oc[4];
#pragma unroll
  for (int dt = 0; dt < 4; ++dt) Oc[dt] = (f32x4){0.f, 0.f, 0.f, 0.f};
#define CMP_SCORES(rg_, cbase_) \
    f32x4 sa = {0.f, 0.f, 0.f, 0.f}, sb = {0.f, 0.f, 0.f, 0.f}; \
    _Pragma("unroll") for (int ks = 0; ks < 2; ++ks) { sa = MFMA16(__builtin_bit_cast(bf16x8, rg_.ka[ks]), qf[ks], sa); sb = MFMA16(__builtin_bit_cast(bf16x8, rg_.kb[ks]), qf[ks], sb); }
#define CMP_P1(rg_, cbase_) { CMP_SCORES(rg_, cbase_) float mx = m; \
    _Pragma("unroll") for (int i = 0; i < 4; ++i) { const int ca = (cbase_) + 8 * quad + i; const float va = ca < ncv ? sa[i] * 0.125f : -1e30f, vb = ca + 4 < ncv ? sb[i] * 0.125f : -1e30f; sa[i] = va; sb[i] = vb; mx = fmaxf(mx, fmaxf(va, vb)); } \
    mx = fmaxf(mx, __shfl_xor(mx, 16)); mx = fmaxf(mx, __shfl_xor(mx, 32)); \
    const float corr = fexp(m - mx); m = mx; float ps = 0.f; \
    _Pragma("unroll") for (int i = 0; i < 4; ++i) ps += (sa[i] > -1e29f ? fexp(sa[i] - mx) : 0.f) + (sb[i] > -1e29f ? fexp(sb[i] - mx) : 0.f); \
    lsum = lsum * corr + ps; }
#define CMP_P2(rg_, cbase_) { CMP_SCORES(rg_, cbase_) float ga = 0.f, gb = 0.f; \
    _Pragma("unroll") for (int i = 0; i < 4; ++i) { const int ca = (cbase_) + 8 * quad + i; const float pa = ca < ncv ? fexp(sa[i] * 0.125f - m) * inv : 0.f, pb = ca + 4 < ncv ? fexp(sb[i] * 0.125f - m) * inv : 0.f; \
      sa[i] = pa; sb[i] = pb; ga += pa; gb += pb; } \
    float ca3 = sa[3], cb3 = sb[3]; \
    ga += __shfl_xor(ga, 1); ga += __shfl_xor(ga, 2); gb += __shfl_xor(gb, 1); gb += __shfl_xor(gb, 2); \
    ca3 += __shfl_xor(ca3, 1); ca3 += __shfl_xor(ca3, 2); cb3 += __shfl_xor(cb3, 1); cb3 += __shfl_xor(cb3, 2); \
    if (hd == 0) { const int j = ((cbase_) >> 2) + 2 * quad; Gs[tk * 132 + j] = ga; Gs[tk * 132 + j + 1] = gb; Cs[tk * 132 + j + 1] = ca3; Cs[tk * 132 + j + 2] = cb3; } \
    bf16x8 pf; \
    _Pragma("unroll") for (int i = 0; i < 4; ++i) { pf[i] = (short)f2bf(sa[i]); pf[4 + i] = (short)f2bf(sb[i]); } \
    _Pragma("unroll") for (int dt = 0; dt < 4; ++dt) Oc[dt] = MFMA16(__builtin_bit_cast(bf16x8, rg_.v[dt]), pf, Oc[dt]); }
#define CMP_ISSUE(rg_, st_) sel_issue(rg_, kc + (size_t)((st_) * 32) * 64, 64, vcT + (st_) * 32, CLD, rowa, l15, quad)
  if (nstep > 0) {
    CMP_ISSUE(c0r, 0);
    for (int st = 0; st < nstep; st += 2) {
      sel_wait(c0r); CMP_ISSUE(c1r, (st + 1 < nstep ? st + 1 : st)); CMP_P1(c0r, st * 32)
      sel_wait(c1r); CMP_ISSUE(c0r, (st + 2 < nstep ? st + 2 : 0)); if (st + 1 < nstep) CMP_P1(c1r, (st + 1) * 32)
    }
    sel_wait(c0r);
  }
  lsum += __shfl_xor(lsum, 16); lsum += __shfl_xor(lsum, 32);
  const float inv = lsum > 0.f ? 1.f / lsum : 0.f;
  WAVE_SYNC();
  if (nstep > 0) {
    for (int st = 0; st < nstep; st += 2) {
      sel_wait(c0r); CMP_ISSUE(c1r, (st + 1 < nstep ? st + 1 : st)); CMP_P2(c0r, st * 32)
      sel_wait(c1r); CMP_ISSUE(c0r, (st + 2 < nstep ? st + 2 : st)); if (st + 1 < nstep) CMP_P2(c1r, (st + 1) * 32)
    }
    sel_wait(c0r);
  }
#undef CMP_SCORES
#undef CMP_P1
#undef CMP_P2
#undef CMP_ISSUE
  WAVE_SYNC();
  for (int i = lane; i < 512; i += 64) { const int t2 = i >> 7, j = i & 127; const bool valid = j <= cur, forced = valid && (j == 0 || j == cur || j == cur - 1);
    const float im = Gs[t2 * 132 + j] + Cs[t2 * 132 + j]; Gs[t2 * 132 + j] = forced ? 1e4f : (valid ? im : -1e4f); }
  WAVE_SYNC();
  unsigned long long mlo[4] = {0ull, 0ull, 0ull, 0ull}, mhi[4] = {0ull, 0ull, 0ull, 0ull};
  if (cur < 16) {
#pragma unroll
    for (int t2 = 0; t2 < 4; ++t2) mlo[t2] = (1ull << (cur + 1)) - 1ull;
  } else {
    const int tkr = lane >> 4, sub = lane & 15; float v[8]; int rank[8];
#pragma unroll
    for (int mm = 0; mm < 8; ++mm) { v[mm] = Gs[tkr * 132 + sub + 16 * mm]; rank[mm] = 0; }
#pragma unroll 8
    for (int j2 = 0; j2 <= cur; ++j2) { const float o = Gs[tkr * 132 + j2];
#pragma unroll
      for (int mm = 0; mm < 8; ++mm) rank[mm] += (o > v[mm] || (o == v[mm] && j2 < sub + 16 * mm)) ? 1 : 0; }
#pragma unroll
    for (int mm = 0; mm < 8; ++mm) { const unsigned long long bal = __ballot((sub + 16 * mm <= cur) && rank[mm] < 16);
#pragma unroll
      for (int t2 = 0; t2 < 4; ++t2) { const unsigned long long field = (bal >> (16 * t2)) & 0xffffull; if (mm < 4) mlo[t2] |= field << (16 * mm); else mhi[t2] |= field << (16 * (mm - 4)); } }
  }
  const unsigned long long ulo = mlo[0] | mlo[1] | mlo[2] | mlo[3], uhi = mhi[0] | mhi[1] | mhi[2] | mhi[3];
  const int nlo = __popcll(ulo), nblk = nlo + __popcll(uhi);
  { const unsigned long long below = (1ull << lane) - 1ull;
    if ((ulo >> lane) & 1ull) { int tm = 0;
#pragma unroll
      for (int t2 = 0; t2 < 4; ++t2) tm |= (int)((mlo[t2] >> lane) & 1ull) << t2;
      blist[__popcll(ulo & below)] = lane | (tm << 8); }
    if ((uhi >> lane) & 1ull) { int tm = 0;
#pragma unroll
      for (int t2 = 0; t2 < 4; ++t2) tm |= (int)((mhi[t2] >> lane) & 1ull) << t2;
      blist[nlo + __popcll(uhi & below)] = (lane + 64) | (tm << 8); } }
  WAVE_SYNC();
  float m2 = -1e30f, l2 = 0.f; f32x4 Os[4];
#pragma unroll
  for (int dt = 0; dt < 4; ++dt) Os[dt] = (f32x4){0.f, 0.f, 0.f, 0.f};
  const int nh = 2 * nblk;
  SelRegs r0, r1;
  { const int e0 = __builtin_amdgcn_readfirstlane(blist[0]); sel_issue(r0, projb + (size_t)((e0 & 255) * 64) * LDP + C_NKS, LDP, vsT + (e0 & 255) * 64, VLD, rowa, l15, quad); }
  for (int hs = 0; hs < nh; hs += 2) {
    const int e = __builtin_amdgcn_readfirstlane(blist[hs >> 1]); const int kb0 = (e & 255) * 64; const bool colsel = ((e >> (8 + tk)) & 1) != 0;
    sel_wait(r0);
    sel_issue(r1, projb + (size_t)(kb0 + 32) * LDP + C_NKS, LDP, vsT + kb0 + 32, VLD, rowa, l15, quad);
    sel_compute(r0, qf, kb0, colsel, stk, quad, m2, l2, Os);
    sel_wait(r1);
    { const int en = __builtin_amdgcn_readfirstlane(blist[(hs + 2 < nh ? hs + 2 : hs) >> 1]); sel_issue(r0, projb + (size_t)((en & 255) * 64) * LDP + C_NKS, LDP, vsT + (en & 255) * 64, VLD, rowa, l15, quad); }
    sel_compute(r1, qf, kb0 + 32, colsel, stk, quad, m2, l2, Os);
  }
  sel_wait(r0);
  l2 += __shfl_xor(l2, 16); l2 += __shfl_xor(l2, 32);
  const float inv2 = 1.f / l2;
  const size_t tok = (size_t)(b * S_ + stk);
  const bf16_t* prow = projb + (size_t)stk * LDP;
  const float g0 = 1.f / (1.f + __expf(-bf2f(prow[C_NG + hd * 3]))), g1 = 1.f / (1.f + __expf(-bf2f(prow[C_NG + hd * 3 + 1]))), g2 = 1.f / (1.f + __expf(-bf2f(prow[C_NG + hd * 3 + 2])));
  const bf16_t* ow = (const bf16_t*)(p.ws + OFF_OWIN) + tok * 256 + hd * 64; bf16_t* mix = (bf16_t*)(p.ws + OFF_XB) + tok * D_ + 512 + hd * 64;
#pragma unroll
  for (int dt = 0; dt < 4; ++dt) { const int dv = dt * 16 + 4 * quad; const uint2 wv = *(const uint2*)(ow + dv);
    const float w0 = __uint_as_float(wv.x << 16), w1 = __uint_as_float(wv.x & 0xffff0000u), w2 = __uint_as_float(wv.y << 16), w3 = __uint_as_float(wv.y & 0xffff0000u);
    uint2 pk; pk.x = pack2(g0 * Oc[dt][0] + g1 * Os[dt][0] * inv2 + g2 * w0, g0 * Oc[dt][1] + g1 * Os[dt][1] * inv2 + g2 * w1);
    pk.y = pack2(g0 * Oc[dt][2] + g1 * Os[dt][2] * inv2 + g2 * w2, g0 * Oc[dt][3] + g1 * Os[dt][3] * inv2 + g2 * w3);
    *(uint2*)(mix + dv) = pk; }
}

DI int q_pop(unsigned* ctr, char* smem) {
  int* sh = (int*)(smem + 65024);
  __syncthreads();
  if (tid_() == 0) *sh = (int)atomicAdd(ctr, 1u);
  __syncthreads();
  return *sh;
}
DI void m1_phase(const Params& p, int l, char* smem, int cslot = 0, int skip = 0) {
  unsigned* ctr = (unsigned*)(p.ws + OFF_CNT) + cslot;
  const int total = 32 + 64 * 24 + 256;
  bool first = true;
  for (;;) {
    const int it = (first ? (int)blockIdx.x : q_pop(ctr, smem) + (int)gridDim.x) + skip; first = false;
    if (it >= total) break;
#ifndef M1SEL
#define M1SEL 31
#endif
    if (it < 32) { if (M1SEL & 1) gdn_chain(p, it, smem); }
    else if (it < 32 + 256) { if (M1SEL & 16) nsa_compress(p, l, it - 32, smem); }
    else { const int j = it - 288, qb = 63 - j / 24, k = j % 24, kind = k >> 3, bh = k & 7, b = bh >> 2, hh = bh & 3;
      if (kind == 0) { if (M1SEL & 2) sb_item(p, b, hh, qb, smem); } else if (kind == 1) { if (M1SEL & 4) diff_item(p, l, b, hh, qb, smem); } else { if (M1SEL & 8) win_item(p, b, hh, qb, smem); } }
  }
}
DI void m2_phase(const Params& p, int l, char* smem, int cslot = 16) {
  unsigned* ctr = (unsigned*)(p.ws + OFF_CNT) + cslot;
  const int total = 1024, wave = tid_() >> 6;
  for (int it = blockIdx.x; it < 1024; it += gridDim.x) gdn_g3(p, l, it, smem);
  bool first = true;
  for (;;) {
    const int it = first ? (int)blockIdx.x : q_pop(ctr, smem) + (int)gridDim.x;
    if (first) __syncthreads();
    first = false;
    if (it >= total) break;
    { const int item = 1023 - it;
      nsa_group(p, item * 16 + wave * 4, (float*)smem + wave * 1152); }
  }
}

struct XB { unsigned x, nloc, nx; };
#define XB_XCNT(j) (64 * (j))
#define XB_XSUB(j) (64 * (16 + (j)))
#define XB_XGEN(j) (64 * (32 + (j)))
#define XB_TOP (64 * 48)
#define XB_TOPGEN (64 * 49)
DI unsigned xb_ld(unsigned* p) { return __hip_atomic_load(p, __ATOMIC_RELAXED, __HIP_MEMORY_SCOPE_AGENT); }
DI unsigned xb_add(unsigned* p, unsigned v) { return __hip_atomic_fetch_add(p, v, __ATOMIC_RELAXED, __HIP_MEMORY_SCOPE_AGENT); }
DI unsigned xb_xcc_id() { return (unsigned)__builtin_amdgcn_s_getreg((3 << 11) | 20) & 0xFu; }
#define XB_SPIN(cond) do { unsigned sp_ = 0; while ((cond) && ++sp_ < (1u << 24)) __builtin_amdgcn_s_sleep(1); } while (0)
DI void xcd_barrier(unsigned* bar, const XB& b) {
  asm volatile("s_waitcnt vmcnt(0)" ::: "memory");
  __syncthreads();
  if (tid_() == 0) {
    asm volatile("s_waitcnt vmcnt(0) lgkmcnt(0)" ::: "memory");
    const unsigned old = xb_add(bar + XB_XSUB(b.x), 1u), gen = old / b.nloc;
    if (old + 1u == (gen + 1u) * b.nloc) {
      __builtin_amdgcn_fence(__ATOMIC_RELEASE, "agent");
      asm volatile("s_waitcnt vmcnt(0)" ::: "memory");
      const unsigned og = xb_add(bar + XB_TOP, 1u), tg = og / b.nx;
      if (og + 1u == (tg + 1u) * b.nx) xb_add(bar + XB_TOPGEN, 1u);
      else XB_SPIN(xb_ld(bar + XB_TOPGEN) == tg);
      __builtin_amdgcn_fence(__ATOMIC_ACQUIRE, "agent");
      xb_add(bar + XB_XGEN(b.x), 1u);
      asm volatile("s_waitcnt vmcnt(0)" ::: "memory");
    } else {
      XB_SPIN(xb_ld(bar + XB_XGEN(b.x)) == gen);
      __builtin_amdgcn_fence(__ATOMIC_ACQUIRE, "agent");
      asm volatile("s_waitcnt vmcnt(0)" ::: "memory");
    }
  }
  __syncthreads();
}
constexpr int NPHASE = 25;
DI void run_phase(const Params& p, int ph, char* smem) {
  if (ph == 0) { prologue_phase(p); convert_weights(p, 0, 1, smem); return; }
  const int l = (ph - 1) / 12, sp = (ph - 1) % 12;
  const float alpha = 1.4142135623730951f;
  bf16_t* xb = (bf16_t*)(p.ws + OFF_XB); bf16_t* big = (bf16_t*)(p.ws + OFF_BIG);
  const bf16_t* wgu = (const bf16_t*)(p.ws + OFF_GU); const bf16_t* wdn = (const bf16_t*)(p.ws + OFF_DN);
  EpiArgs e; e.obf = big; e.resid = p.out; e.of32 = p.out; e.alpha = alpha; e.sc = 0.5f; e.rope = (const float*)(p.ws + OFF_ROPE);
  switch (sp) {
    case 0: case 9: gemm_phase<0>(xb, D_, wgu, D_, 2 * DFF, smem, e); break;
    case 1: if (l == 0) e.resid = p.x; gemm_phase<2>(big, DFF, wdn, DFF, D_, smem, e); break;
    case 10: gemm_phase<2>(big, DFF, wdn, DFF, D_, smem, e); break;
    case 2: ln_phase(p.out, xb, p.ln1g + l * D_, p.ln1b + l * D_); break;
    case 3: gemm_phase<1>(xb, D_, (const bf16_t*)(p.ws + OFF_WIN), D_, LDP, smem, e); break;
    case 4: m0_phase(p, l, smem); break;
    case 5: m1_phase(p, l, smem); break;
    case 6: m2_phase(p, l, smem); break;
    case 7: e.sc = 1.f; gemm_phase<2>(xb, D_, (const bf16_t*)(p.ws + OFF_WOUT), D_, D_, smem, e); break;
    case 8: ln_phase(p.out, xb, p.ln2g + l * D_, p.ln2b + l * D_); convert_weights(p, l, 2, smem); break;
    case 11: ln_phase(p.out, xb, p.ln3g + l * D_, p.ln3b + l * D_); if (l + 1 < 2) convert_weights(p, l + 1, 1, smem); break;
  }
}
__global__ void __launch_bounds__(256, 2) mega(Params p, int ph0, int ph1, int coop) {
  __shared__ __attribute__((aligned(16))) char smem[65536];
#ifdef PHASE_ONLY
  run_phase(p, PHASE_ONLY, smem); return;
#endif
  XB xb; xb.x = xb_xcc_id(); xb.nloc = 1u; xb.nx = 1u;
  unsigned* bar = (unsigned*)(p.ws + OFF_BAR);
  if (coop && tid_() == 0) xb_add(bar + XB_XCNT(xb.x), 1u);
  for (int ph = ph0; ph < ph1; ++ph) {
    const Params& q = p;
    run_phase(q, ph, smem);
#ifdef PROBE_DUP
    { const int sp = (ph - 1) % 12; const int l = (ph - 1) / 12;
      if (ph > 0 && PROBE_DUP == 1 && (sp == 0 || sp == 9)) { cg::this_grid().sync(); run_phase(q, ph, smem); }
      if (ph > 0 && PROBE_DUP == 2 && sp == 5) { cg::this_grid().sync(); m1_phase(q, l, smem, 32, 32); }
      if (ph > 0 && PROBE_DUP == 3 && sp == 6) { cg::this_grid().sync(); m2_phase(q, l, smem, 48); }
      if (ph > 0 && PROBE_DUP == 6 && sp == 6) { cg::this_grid().sync(); for (int it = blockIdx.x; it < 1024; it += gridDim.x) gdn_g3(q, l, it, smem); }
      if (ph > 0 && PROBE_DUP == 7 && sp == 4) { cg::this_grid().sync(); for (int it = blockIdx.x; it < 2560; it += gridDim.x) vt_tile(q, it, smem); }
      if (PROBE_DUP == 8 && ph < 20) { cg::this_grid().sync(); cg::this_grid().sync(); }
      if (ph > 0 && PROBE_DUP == 4 && sp == 3) { cg::this_grid().sync(); run_phase(q, ph, smem); }
      if (ph > 0 && PROBE_DUP == 5 && sp == 4) { cg::this_grid().sync(); for (int it = blockIdx.x; it < 2560 + 1024; it += gridDim.x) { if (it < 1024) gdn_g1(q, l, it, smem); else vt_tile(q, it - 1024, smem); } } }
#endif
    if (coop && ph + 1 < ph1) {
      if (ph == 0) { cg::this_grid().sync();
        unsigned mine = 0u, cnt = 0u;
        for (unsigned j = 0; j < 16; ++j) { const unsigned c = xb_ld(bar + XB_XCNT(j)); cnt += c > 0u ? 1u : 0u; mine = (j == xb.x) ? c : mine; }
        xb.nloc = mine > 0u ? mine : 1u; xb.nx = cnt > 0u ? cnt : 1u; }
      else xcd_barrier(bar, xb);
    }
  }
}

extern "C" void kernel_launch(void* const* d_in, const int* in_sizes, int n_in, void* d_out, int out_size, void* d_ws, size_t ws_size, hipStream_t stream) {
  Params p{};
  const float** f = (const float**)&p;
  for (int i = 0; i < 28; ++i) f[i] = (const float*)d_in[i];
  p.out = (float*)d_out; p.ws = (char*)d_ws;
  static int grid_blocks = 0;
  if (!grid_blocks) {
    int dev = 0, cus = 0, per_cu = 0;
    hipGetDevice(&dev);
    hipDeviceGetAttribute(&cus, hipDeviceAttributeMultiprocessorCount, dev);
    hipOccupancyMaxActiveBlocksPerMultiprocessor(&per_cu, mega, 256, 0);
    if (per_cu < 1) per_cu = 1;
    if (per_cu > 2) per_cu = 2;
    grid_blocks = cus * per_cu;
  }
  if (ws_size < WS_NEED) { fprintf(stderr, "workspace too small: %zu < %zu\n", ws_size, (size_t)WS_NEED); return; }
#if MK_COOP
  hipMemsetAsync((char*)d_ws + OFF_BAR, 0, 32768, stream);
  int ph0 = 0, ph1 = NPHASE, coop = 1;
  void* args[] = {&p, &ph0, &ph1, &coop};
  hipError_t e = hipLaunchCooperativeKernel((void*)mega, dim3(grid_blocks), dim3(256), args, 0, stream);
  if (e != hipSuccess) fprintf(stderr, "cooperative launch failed: %s (grid %d)\n", hipGetErrorString(e), grid_blocks);
#else
  for (int ph = 0; ph < NPHASE; ++ph) hipLaunchKernelGGL(mega, dim3(grid_blocks), dim3(256), 0, stream, p, ph, ph + 1, 0);
#endif
}
```

```cpp
#include <hip/hip_runtime.h>
#include <hip/hip_cooperative_groups.h>
#include <stdint.h>
#include <cstdio>
namespace cg = cooperative_groups;

#ifndef MK_COOP
#define MK_COOP 1
#endif

#define DI __device__ __forceinline__
typedef unsigned short bf16_t;
typedef short bf16x8 __attribute__((ext_vector_type(8)));
typedef short s16x4 __attribute__((ext_vector_type(4)));
typedef float f32x4 __attribute__((ext_vector_type(4)));
typedef float f32x16 __attribute__((ext_vector_type(16)));
typedef unsigned u32x4 __attribute__((ext_vector_type(4)));

constexpr int T_ = 16384, S_ = 8192, D_ = 1024, DFF = 2816, LDP = 3328;
constexpr int VLD = T_ + 128;
constexpr int CLD = 544;
constexpr int C_DQ1 = 0, C_DQ2 = 128, C_DK1 = 256, C_DK2 = 384, C_DV = 512, C_GQ = 768, C_GK = 1024, C_GV = 1280, C_GZ = 1536,
              C_NQ = 1792, C_NKC = 2048, C_NVC = 2112, C_NKS = 2176, C_NVS = 2240, C_NKW = 2304, C_NVW = 2368,
              C_SQ = 2432, C_SK = 2688, C_SV = 2944, C_GA = 3200, C_GB = 3204, C_NG = 3208;

constexpr size_t OFF_GU = 0, OFF_DN = 11534336, OFF_WIN = OFF_DN + 5767168, OFF_WOUT = OFF_WIN + 6815744;
constexpr size_t OFF_VT = 0;
constexpr size_t OFF_XB = OFF_WOUT + 2097152;
constexpr size_t OFF_BIG = OFF_XB + 33554432;
constexpr size_t OFF_GU_ = OFF_BIG + 109051904;
constexpr size_t OFF_GW = OFF_GU_ + 16777216, OFF_GKD = OFF_GW + 16777216, OFF_GS = OFF_GKD + 16777216;
constexpr size_t OFF_OWIN = OFF_GS + 16777216;
constexpr size_t OFF_ROPE = OFF_OWIN + 8388608;
constexpr size_t OFF_KCMP = OFF_ROPE + 3145728, OFF_VCMP = OFF_KCMP + 262144;
constexpr size_t OFF_GLAST = OFF_VCMP + 262144;
constexpr size_t OFF_CNT = OFF_GLAST + 4096;
constexpr size_t OFF_BAR = OFF_CNT + 512;
constexpr size_t WS_NEED = OFF_BAR + 32768;

struct Params {
  const float *x, *w_in, *w_out, *gu1, *dn1, *gu2, *dn2;
  const float *ln1g, *ln1b, *ln2g, *ln2b, *ln3g, *ln3b;
  const float *lq1, *lk1, *lq2, *lk2, *subln;
  const float *convw, *alog, *dtb, *gdng;
  const float *pek, *pev, *ckw1, *ckw2, *cvw1, *cvw2;
  float* out; char* ws;
};

DI int tid_() { int t = __builtin_amdgcn_workitem_id_x(); asm volatile("" : "+v"(t)); return t; }
DI float bf2f(bf16_t v) { return __uint_as_float(((unsigned)v) << 16); }
DI bf16_t f2bf(float f) { unsigned u = __float_as_uint(f); u += 0x7fffu + ((u >> 16) & 1u); return (bf16_t)(u >> 16); }
DI unsigned pack2(float a, float b) { return (unsigned)f2bf(a) | ((unsigned)f2bf(b) << 16); }
DI float fexp2(float x) { return __builtin_amdgcn_exp2f(x); }
DI float fexp(float x) { return __builtin_amdgcn_exp2f(x * 1.4426950408889634f); }
DI float flog(float x) { return __builtin_amdgcn_logf(x) * 0.6931471805599453f; }
DI float wave_max(float v) { for (int o = 32; o >= 1; o >>= 1) v = fmaxf(v, __shfl_xor(v, o)); return v; }
DI float wave_sum(float v) { for (int o = 32; o >= 1; o >>= 1) v += __shfl_xor(v, o); return v; }
#define WAVE_SYNC() do { __builtin_amdgcn_fence(__ATOMIC_RELEASE, "wavefront"); __builtin_amdgcn_wave_barrier(); __builtin_amdgcn_fence(__ATOMIC_ACQUIRE, "wavefront"); } while (0)
DI uint4 gld16(const void* p) { uint4 r; asm volatile("global_load_dwordx4 %0, %1, off" : "=v"(r) : "v"(p) : "memory"); return r; }
DI float4 gldf4(const void* p) { float4 r; asm volatile("global_load_dwordx4 %0, %1, off" : "=v"(r) : "v"(p) : "memory"); return r; }
DI u32x4 gldv(const void* p) { u32x4 r; asm volatile("global_load_dwordx4 %0, %1, off" : "=v"(r) : "v"(p) : "memory"); return r; }
DI f32x4 gldfv(const void* p) { f32x4 r; asm volatile("global_load_dwordx4 %0, %1, off" : "=v"(r) : "v"(p) : "memory"); return r; }
DI float gld32(const void* p) { float r; asm volatile("global_load_dword %0, %1, off" : "=v"(r) : "v"(p) : "memory"); return r; }
DI void vm_wait0() { asm volatile("s_waitcnt vmcnt(0)" ::: "memory"); }
DI int crow(int i, int h) { return (i & 3) + 8 * (i >> 2) + 4 * h; }
#define MFMA16(a, b, c) __builtin_amdgcn_mfma_f32_16x16x32_bf16((a), (b), (c), 0, 0, 0)
#define MFMA32(a, b, c) __builtin_amdgcn_mfma_f32_32x32x16_bf16((a), (b), (c), 0, 0, 0)

DI int src_col(int n, int mode) {
  if (mode == 1) { int t16 = n >> 4; return (t16 & 1) * DFF + (t16 >> 1) * 16 + (n & 15); }
  if (mode == 2) {
    if (n < 1792) return n;
    if (n < 2432) return n + 8;
    if (n < 3200) return n + 20;
    if (n < 3208) return 1792 + (n - 3200);
    if (n < 3220) return 2440 + (n - 3208);
    return -1;
  }
  return n;
}
DI void conv_tile(const float* __restrict__ W, int K, int N, bf16_t* __restrict__ Wt, int mode, int tile, char* smem) {
  float* tl = (float*)smem;
  const int nK = K >> 6, kt = tile % nK, nt = tile / nK, k0 = kt * 64, n0 = nt * 64, tid = tid_();
  __syncthreads();
  { const int c = tid & 63, sc = src_col(n0 + c, mode); const int scc = sc >= 0 ? sc : 0; float wv[16];
#pragma unroll
    for (int i = 0; i < 16; ++i) wv[i] = gld32(W + (size_t)(k0 + (tid >> 6) + 4 * i) * N + scc);
    asm volatile("s_waitcnt vmcnt(0)" : "+v"(wv[0]), "+v"(wv[1]), "+v"(wv[2]), "+v"(wv[3]), "+v"(wv[4]), "+v"(wv[5]), "+v"(wv[6]), "+v"(wv[7]), "+v"(wv[8]), "+v"(wv[9]), "+v"(wv[10]), "+v"(wv[11]), "+v"(wv[12]), "+v"(wv[13]), "+v"(wv[14]), "+v"(wv[15]) :: "memory");
#pragma unroll
    for (int i = 0; i < 16; ++i) { const int r = (tid >> 6) + 4 * i; tl[r * 65 + c] = (sc >= 0) ? wv[i] : 0.f; } }
  __syncthreads();
  { const int kk2 = (tid & 31) * 2;
#pragma unroll
    for (int i = 0; i < 8; ++i) { const int nn = (tid >> 5) + 8 * i; *(unsigned*)(Wt + (size_t)(n0 + nn) * K + k0 + kk2) = pack2(tl[kk2 * 65 + nn], tl[(kk2 + 1) * 65 + nn]); } }
}
DI void convert_weights(const Params& p, int l, int which  , char* smem) {
  bf16_t* gu = (bf16_t*)(p.ws + OFF_GU); bf16_t* dn = (bf16_t*)(p.ws + OFF_DN);
  const float* sgu = (which == 1 ? p.gu1 : p.gu2) + (size_t)l * D_ * 2 * DFF;
  const float* sdn = (which == 1 ? p.dn1 : p.dn2) + (size_t)l * DFF * D_;
  const int n_gu = 16 * 88, n_dn = 44 * 16, n_in = (which == 1) ? 16 * 52 : 0, n_out = (which == 1) ? 256 : 0;
  const int total = n_gu + n_dn + n_in + n_out;
  for (int it = blockIdx.x; it < total; it += gridDim.x) {
    if (it < n_gu) conv_tile(sgu, D_, 2 * DFF, gu, 1, it, smem);
    else if (it < n_gu + n_dn) conv_tile(sdn, DFF, D_, dn, 0, it - n_gu, smem);
    else if (it < n_gu + n_dn + n_in) conv_tile(p.w_in + (size_t)l * D_ * 3220, D_, 3220, (bf16_t*)(p.ws + OFF_WIN), 2, it - n_gu - n_dn, smem);
    else conv_tile(p.w_out + (size_t)l * D_ * D_, D_, D_, (bf16_t*)(p.ws + OFF_WOUT), 0, it - n_gu - n_dn - n_in, smem);
  }
}

struct EpiArgs { bf16_t* obf; const float* resid; float* of32; float alpha, sc; const float* rope; };
DI void vm_wait8() { asm volatile("s_waitcnt vmcnt(8)" ::: "memory"); }
template <int EPI>
DI void gemm_epilogue(f32x4 (&acc)[4][4], int m0, int n0, int wm, int wn, int l15, int quad, const EpiArgs& e) {
#pragma unroll
  for (int mt = 0; mt < 4; ++mt) {
    const size_t row = (size_t)(m0 + wm * 64 + mt * 16 + l15);
    if (EPI == 0) {
#pragma unroll
      for (int q = 0; q < 2; ++q) {
        const int j = ((n0 >> 5) + wn * 2 + q) * 16 + 4 * quad; float hv[4];
#pragma unroll
        for (int i = 0; i < 4; ++i) { const float g = acc[mt][2 * q][i], u = acc[mt][2 * q + 1][i]; hv[i] = g * __builtin_amdgcn_rcpf(1.f + fexp(-g)) * u; }
        *(uint2*)(e.obf + row * DFF + j) = (uint2){pack2(hv[0], hv[1]), pack2(hv[2], hv[3])};
      }
    } else if (EPI == 1) {
      const int cb = n0 + wn * 64, spos = (int)(row & (size_t)(S_ - 1));
      const bool rd = cb < 512, rn = (cb >= C_NQ && cb < C_NKC + 64) || cb == C_NKS || cb == C_NKW;
      if (rd) {
        const f32x4 cs = *(const f32x4*)(e.rope + spos * 16 + 4 * quad), sn = *(const f32x4*)(e.rope + S_ * 16 + spos * 16 + 4 * quad);
#pragma unroll
        for (int g = 0; g < 2; ++g) { const f32x4 t1 = acc[mt][2 * g], t2 = acc[mt][2 * g + 1]; acc[mt][2 * g] = t1 * cs - t2 * sn; acc[mt][2 * g + 1] = t2 * cs + t1 * sn; }
      } else if (rn) {
#pragma unroll
        for (int g = 0; g < 2; ++g) {
          const f32x4 cs = *(const f32x4*)(e.rope + S_ * 32 + spos * 32 + g * 16 + 4 * quad), sn = *(const f32x4*)(e.rope + S_ * 64 + spos * 32 + g * 16 + 4 * quad);
          const f32x4 t1 = acc[mt][g], t2 = acc[mt][g + 2]; acc[mt][g] = t1 * cs - t2 * sn; acc[mt][g + 2] = t2 * cs + t1 * sn; }
      }
#pragma unroll
      for (int nt = 0; nt < 4; ++nt) { const int col = n0 + wn * 64 + nt * 16 + 4 * quad;
        *(uint2*)(e.obf + row * LDP + col) = (uint2){pack2(acc[mt][nt][0], acc[mt][nt][1]), pack2(acc[mt][nt][2], acc[mt][nt][3])}; }
    } else {
      float4 rv[4];
#pragma unroll
      for (int nt = 0; nt < 4; ++nt) rv[nt] = *(const float4*)(e.resid + row * D_ + n0 + wn * 64 + nt * 16 + 4 * quad);
#pragma unroll
      for (int nt = 0; nt < 4; ++nt) { const f32x4 a = acc[mt][nt];
        *(float4*)(e.of32 + row * D_ + n0 + wn * 64 + nt * 16 + 4 * quad) = (float4){e.alpha * rv[nt].x + e.sc * a[0], e.alpha * rv[nt].y + e.sc * a[1], e.alpha * rv[nt].z + e.sc * a[2], e.alpha * rv[nt].w + e.sc * a[3]}; }
    }
  }
#pragma unroll
  for (int i = 0; i < 4; ++i)
#pragma unroll
    for (int j = 0; j < 4; ++j) acc[i][j] = (f32x4){0.f, 0.f, 0.f, 0.f};
}
DI void gemm_compute(const bf16_t* sb, int wm, int wn, int l15, int quad, f32x4 (&acc)[4][4]) {
#pragma unroll
  for (int ks = 0; ks < 2; ++ks) {
    bf16x8 af[4], bfr[4];
#pragma unroll
    for (int mt = 0; mt < 4; ++mt) af[mt] = *(const bf16x8*)(sb + ((ks * 4 + quad) * 128 + wm * 64 + mt * 16 + (l15 & 8) + ((l15 + ks * 4 + quad) & 7)) * 8);
#pragma unroll
    for (int nt = 0; nt < 4; ++nt) bfr[nt] = *(const bf16x8*)(sb + 8192 + ((ks * 4 + quad) * 128 + wn * 64 + nt * 16 + (l15 & 8) + ((l15 + ks * 4 + quad) & 7)) * 8);
#pragma unroll
    for (int mt = 0; mt < 4; ++mt)
#pragma unroll
      for (int nt = 0; nt < 4; ++nt) acc[mt][nt] = MFMA16(af[mt], bfr[nt], acc[mt][nt]);
  }
}
DI void gemm_compute_sw(const bf16_t* sb, int wm, int wn, int l15, int quad, f32x4 (&acc)[4][4]) {
#pragma unroll
  for (int ks = 0; ks < 2; ++ks) {
    bf16x8 af[4], bfr[4];
    const int sl = ((ks * 4 + quad) ^ ((l15 >> 1) & 7)) * 8;
#pragma unroll
    for (int mt = 0; mt < 4; ++mt) af[mt] = *(const bf16x8*)(sb + (wm * 64 + mt * 16 + l15) * 64 + sl);
#pragma unroll
    for (int nt = 0; nt < 4; ++nt) bfr[nt] = *(const bf16x8*)(sb + 8192 + (wn * 64 + nt * 16 + l15) * 64 + sl);
#pragma unroll
    for (int mt = 0; mt < 4; ++mt)
#pragma unroll
      for (int nt = 0; nt < 4; ++nt) acc[mt][nt] = MFMA16(bfr[nt], af[mt], acc[mt][nt]);
  }
}
template <int EPI>
DI void gemm_phase(const bf16_t* __restrict__ A, int lda, const bf16_t* __restrict__ Bt, int K, int N, char* smem, const EpiArgs& e) {
  const int NT = N >> 7, ntiles = 128 * NT, nk = K >> 6;
  if ((int)blockIdx.x >= ntiles) return;
  const int cnt = (ntiles - (int)blockIdx.x + (int)gridDim.x - 1) / (int)gridDim.x, total = cnt * nk;
  const int tid = tid_(), lane = tid & 63, wave = __builtin_amdgcn_readfirstlane(tid >> 6), wm = wave >> 1, wn = wave & 1, l15 = lane & 15, quad = lane >> 4;
  bf16_t* sm = (bf16_t*)smem;
  const int lr = wave * 8 + (lane >> 3), lch = (lane & 7) ^ ((lr >> 1) & 7);
#define TILE_MN(tile_, m0_, n0_) { const int x_ = (tile_) & 7, u_ = (tile_) >> 3; m0_ = (x_ * 16 + (u_ & 15)) * 128; n0_ = (u_ >> 4) * 128; }
  int ltile = blockIdx.x, lk = 0, lg = 0; const bf16_t *Ag, *Bg;
  { int m0, n0; TILE_MN(ltile, m0, n0); Ag = A + (size_t)(m0 + lr) * lda + lch * 8; Bg = Bt + (size_t)(n0 + lr) * K + lch * 8; }
#define G_ISSUE(buf_) { bf16_t* sw = sm + (buf_) * 16384 + wave * 512; \
    _Pragma("unroll") for (int q = 0; q < 4; ++q) { \
      __builtin_amdgcn_global_load_lds((const unsigned*)(Ag + (size_t)(32 * q) * lda + lk * 64), (unsigned*)(sw + q * 2048), 16, 0, 0); \
      __builtin_amdgcn_global_load_lds((const unsigned*)(Bg + (size_t)(32 * q) * K + lk * 64), (unsigned*)(sw + 8192 + q * 2048), 16, 0, 0); } \
    if (lg + 1 < total) { ++lg; if (++lk == nk) { lk = 0; ltile += gridDim.x; int m0, n0; TILE_MN(ltile, m0, n0); Ag = A + (size_t)(m0 + lr) * lda + lch * 8; Bg = Bt + (size_t)(n0 + lr) * K + lch * 8; } } }
  f32x4 acc[4][4];
#pragma unroll
  for (int i = 0; i < 4; ++i)
#pragma unroll
    for (int j = 0; j < 4; ++j) acc[i][j] = (f32x4){0.f, 0.f, 0.f, 0.f};
  __syncthreads();
  G_ISSUE(0);
  vm_wait0();
  __syncthreads();
  int ctile = blockIdx.x, ck = 0;
  for (int g = 0; g < total; g += 2) {
    G_ISSUE(1);
    gemm_compute_sw(sm, wm, wn, l15, quad, acc);
    vm_wait0();
    __syncthreads();
    G_ISSUE(0);
    gemm_compute_sw(sm + 16384, wm, wn, l15, quad, acc);
    vm_wait0();
    __syncthreads();
    ck += 2;
    if (ck == nk) { int m0, n0; TILE_MN(ctile, m0, n0); gemm_epilogue<EPI>(acc, m0, n0, wm, wn, l15, quad, e); ck = 0; ctile += gridDim.x; }
  }
#undef G_ISSUE
#undef TILE_MN
}

DI void ln_phase(float* x32, bf16_t* xb, const float* g, const float* b) {
  const int lane = tid_() & 63, wv = tid_() >> 6;
  float4 gg[4], bb[4];
#pragma unroll
  for (int j = 0; j < 4; ++j) { gg[j] = *(const float4*)(g + j * 256 + lane * 4); bb[j] = *(const float4*)(b + j * 256 + lane * 4); }
  for (int row = blockIdx.x * 4 + wv; row < T_; row += gridDim.x * 4) {
    f32x4 v[4];
#pragma unroll
    for (int j = 0; j < 4; ++j) v[j] = gldfv(x32 + (size_t)row * D_ + j * 256 + lane * 4);
    asm volatile("s_waitcnt vmcnt(0)" : "+v"(v[0]), "+v"(v[1]), "+v"(v[2]), "+v"(v[3]) :: "memory");
    float s = 0.f;
#pragma unroll
    for (int j = 0; j < 4; ++j) s += (v[j][0] + v[j][1]) + (v[j][2] + v[j][3]);
    s = wave_sum(s); const float mu = s * (1.f / D_); float q = 0.f;
#pragma unroll
    for (int j = 0; j < 4; ++j) { v[j] -= mu; q += v[j][0] * v[j][0] + v[j][1] * v[j][1] + v[j][2] * v[j][2] + v[j][3] * v[j][3]; }
    q = wave_sum(q); const float rs = rsqrtf(q * (1.f / D_) + 1e-5f);
#pragma unroll
    for (int j = 0; j < 4; ++j) {
      const int c = j * 256 + lane * 4;
      float4 y; y.x = v[j][0] * rs * gg[j].x + bb[j].x; y.y = v[j][1] * rs * gg[j].y + bb[j].y; y.z = v[j][2] * rs * gg[j].z + bb[j].z; y.w = v[j][3] * rs * gg[j].w + bb[j].w;
      *(float4*)(x32 + (size_t)row * D_ + c) = y;
      uint2 pk; pk.x = pack2(y.x, y.y); pk.y = pack2(y.z, y.w); *(uint2*)(xb + (size_t)row * D_ + c) = pk;
    }
  }
}

DI void sincos_d(double r, double& sn, double& cs) {
  const double r2 = r * r; double a = 1.0, c = 1.0;
#pragma unroll
  for (int k = 14; k >= 1; --k) { a = 1.0 - r2 / (double)((2 * k) * (2 * k + 1)) * a; c = 1.0 - r2 / (double)((2 * k - 1) * (2 * k)) * c; }
  sn = r * a; cs = c;
}
DI void prologue_phase(const Params& p) {
  const size_t gt = (size_t)blockIdx.x * 256 + tid_(), gs = (size_t)gridDim.x * 256;
  float* rope = (float*)(p.ws + OFF_ROPE);
  for (size_t idx = gt; idx < (size_t)S_ * 48; idx += gs) {
    const int s = (int)(idx / 48), i = (int)(idx % 48); const int dim = i < 16 ? 32 : 64, fi = i < 16 ? i : i - 16;
    const float inv = powf(10000.f, -((float)(2 * fi) / (float)dim));
    const float ang = (float)s * inv;
    const double a = (double)ang, n = rint(a * 0.15915494309189535), r = a - n * 6.283185307179586;
    double sn, cs; sincos_d(r, sn, cs);
    if (i < 16) { rope[s * 16 + fi] = (float)cs; rope[S_ * 16 + s * 16 + fi] = (float)sn; }
    else { rope[S_ * 32 + s * 32 + fi] = (float)cs; rope[S_ * 64 + s * 32 + fi] = (float)sn; }
  }
  bf16_t* xb = (bf16_t*)(p.ws + OFF_XB);
  for (size_t i4 = gt; i4 < (size_t)T_ * D_ / 4; i4 += gs) {
    const float4 v = ((const float4*)p.x)[i4]; uint2 pk; pk.x = pack2(v.x, v.y); pk.y = pack2(v.z, v.w); ((uint2*)xb)[i4] = pk;
  }
}

DI void rope_phase(const Params& p) {
  bf16_t* proj = (bf16_t*)(p.ws + OFF_BIG); const float* rope = (const float*)(p.ws + OFF_ROPE);
  const size_t gt = (size_t)blockIdx.x * 256 + tid_(), gs = (size_t)gridDim.x * 256;
  for (size_t idx = gt; idx < (size_t)T_ * 60; idx += gs) {
    const int tok = (int)(idx / 60), u = (int)(idx % 60), s = tok & (S_ - 1);
    int c1, half; const float *cp, *sp;
    if (u < 32) { const int g = u >> 1, i0 = (u & 1) * 8; c1 = g * 32 + i0; half = 16; cp = rope + s * 16 + i0; sp = rope + S_ * 16 + s * 16 + i0; }
    else { const int q = u - 32, g = q >> 2, i0 = (q & 3) * 8;
      const int base = g < 4 ? C_NQ + g * 64 : (g == 4 ? C_NKC : (g == 5 ? C_NKS : C_NKW));
      c1 = base + i0; half = 32; cp = rope + S_ * 32 + s * 32 + i0; sp = rope + S_ * 64 + s * 32 + i0; }
    bf16_t* row = proj + (size_t)tok * LDP + c1;
    u32x4 a = gldv(row), bq = gldv(row + half); f32x4 c0 = gldfv(cp), c4 = gldfv(cp + 4), s0 = gldfv(sp), s4 = gldfv(sp + 4);
    asm volatile("s_waitcnt vmcnt(0)" : "+v"(a), "+v"(bq), "+v"(c0), "+v"(c4), "+v"(s0), "+v"(s4) :: "memory");
    u32x4 oa, ob;
#pragma unroll
    for (int w = 0; w < 4; ++w) {
      const float t1a = __uint_as_float(a[w] << 16), t1b = __uint_as_float(a[w] & 0xffff0000u), t2a = __uint_as_float(bq[w] << 16), t2b = __uint_as_float(bq[w] & 0xffff0000u);
      const float ca = w < 2 ? c0[2 * w] : c4[2 * w - 4], cb = w < 2 ? c0[2 * w + 1] : c4[2 * w - 3], sa = w < 2 ? s0[2 * w] : s4[2 * w - 4], sb = w < 2 ? s0[2 * w + 1] : s4[2 * w - 3];
      oa[w] = pack2(t1a * ca - t2a * sa, t1b * cb - t2b * sb); ob[w] = pack2(t2a * ca + t1a * sa, t2b * cb + t1b * sb);
    }
    *(u32x4*)row = oa; *(u32x4*)(row + half) = ob;
  }
}
DI void vt_tile(const Params& p, int item, char* smem) {
  const bf16_t* proj = (const bf16_t*)(p.ws + OFF_BIG); bf16_t* vt = (bf16_t*)(p.ws + OFF_VT);
  const int slot = item >> 8, t0 = (item & 255) * 64, tid = tid_();
  const int col = slot < 4 ? C_DV + slot * 64 : (slot < 8 ? C_SV + (slot - 4) * 64 : (slot == 8 ? C_NVW : C_NVS));
  bf16_t* tl = (bf16_t*)smem;
  __syncthreads();
#pragma unroll
  for (int i = 0; i < 2; ++i) { const int idx = tid + 256 * i, tk = idx >> 3, c = idx & 7;
    const uint4 v = *(const uint4*)(proj + (size_t)(t0 + tk) * LDP + col + c * 8);
    unsigned* d = (unsigned*)(tl + tk * 66 + c * 8); d[0] = v.x; d[1] = v.y; d[2] = v.z; d[3] = v.w; }
  __syncthreads();
#pragma unroll
  for (int i = 0; i < 8; ++i) { const int idx = tid + 256 * i, dv = idx >> 5, t2 = (idx & 31) * 2;
    const unsigned v = (unsigned)tl[t2 * 66 + dv] | ((unsigned)tl[(t2 + 1) * 66 + dv] << 16);
    *(unsigned*)(vt + (size_t)(slot * 64 + dv) * VLD + t0 + t2) = v; }
}
DI void gdn_conv(const Params& p, int l, int b, int hh, int s0, int which, float* dst, int ld, bool norm, float scale) {
  const bf16_t* proj = (const bf16_t*)(p.ws + OFF_BIG);
  const int tid = tid_(), c = tid >> 2, part = tid & 3;
  const int colbase = (which == 0 ? C_GQ : (which == 1 ? C_GK : C_GV)) + hh * 64 + part * 16, wch = which * 256 + hh * 64 + part * 16;
  u32x4 xv[8]; f32x4 wv[16];
#pragma unroll
  for (int j = 0; j < 4; ++j) {
    int sj = s0 + c - 3 + j; if (sj < 0) sj = 0;
    const bf16_t* xr = proj + (size_t)(b * S_ + sj) * LDP + colbase;
    xv[2 * j] = gldv(xr); xv[2 * j + 1] = gldv(xr + 8);
    const float* wr = p.convw + (size_t)(l * 4 + j) * 768 + wch;
#pragma unroll
    for (int q = 0; q < 4; ++q) wv[4 * j + q] = gldfv(wr + 4 * q);
  }
  asm volatile("s_waitcnt vmcnt(0)" : "+v"(xv[0]), "+v"(xv[1]), "+v"(xv[2]), "+v"(xv[3]), "+v"(xv[4]), "+v"(xv[5]), "+v"(xv[6]), "+v"(xv[7]),
               "+v"(wv[0]), "+v"(wv[1]), "+v"(wv[2]), "+v"(wv[3]), "+v"(wv[4]), "+v"(wv[5]), "+v"(wv[6]), "+v"(wv[7]),
               "+v"(wv[8]), "+v"(wv[9]), "+v"(wv[10]), "+v"(wv[11]), "+v"(wv[12]), "+v"(wv[13]), "+v"(wv[14]), "+v"(wv[15]) :: "memory");
  float acc[16];
#pragma unroll
  for (int d = 0; d < 16; ++d) acc[d] = 0.f;
#pragma unroll
  for (int j = 0; j < 4; ++j) {
    const float msk = (s0 + c - 3 + j >= 0) ? 1.f : 0.f;
#pragma unroll
    for (int q = 0; q < 4; ++q) {
      const unsigned x0 = xv[2 * j + (q >> 1)][(q & 1) * 2], x1 = xv[2 * j + (q >> 1)][(q & 1) * 2 + 1]; const f32x4 w = wv[4 * j + q];
      acc[4 * q] += msk * w[0] * __uint_as_float(x0 << 16); acc[4 * q + 1] += msk * w[1] * __uint_as_float(x0 & 0xffff0000u);
      acc[4 * q + 2] += msk * w[2] * __uint_as_float(x1 << 16); acc[4 * q + 3] += msk * w[3] * __uint_as_float(x1 & 0xffff0000u);
    }
  }
  float ss = 0.f;
#pragma unroll
  for (int d = 0; d < 16; ++d) { acc[d] = acc[d] / (1.f + __expf(-acc[d])); ss += acc[d] * acc[d]; }
  if (norm) { ss += __shfl_xor(ss, 1); ss += __shfl_xor(ss, 2); const float rn = rsqrtf(ss + 1e-6f) * scale;
#pragma unroll
    for (int d = 0; d < 16; ++d) acc[d] *= rn; }
#pragma unroll
  for (int d = 0; d < 16; ++d) dst[c * ld + part * 16 + d] = acc[d];
}
DI float softplus_f(float x) { return x > 20.f ? x : log1pf(expf(x)); }
DI void gdn_gates(const Params& p, int l, int b, int hh, int s0, float* sG, float* sBeta) {
  const bf16_t* proj = (const bf16_t*)(p.ws + OFF_BIG); const int tid = tid_();
  if (tid < 64) { const bf16_t* row = proj + (size_t)(b * S_ + s0 + tid) * LDP;
    const float a = bf2f(row[C_GA + hh]), bb = bf2f(row[C_GB + hh]);
    sG[tid] = -expf(p.alog[l * 4 + hh]) * softplus_f(a + p.dtb[l * 4 + hh]); sBeta[tid] = 1.f / (1.f + expf(-bb)); }
  __syncthreads();
  if (tid < 64) { float v = sG[tid];
#pragma unroll
    for (int o = 1; o < 64; o <<= 1) { const float u = __shfl_up(v, o); if (tid >= o) v += u; }
    sG[tid] = v; }
  __syncthreads();
}
DI void gdn_g1(const Params& p, int l, int ch, char* smem) {
  const int b = ch >> 9, hh = (ch >> 7) & 3, n = ch & 127, s0 = n * 64, tid = tid_(), c = tid >> 2, part = tid & 3;
  float* sA = (float*)smem; float* sR = sA + 4096; float* sG = sR + 64 * 129; float* sBeta = sG + 64;
  float* U = (float*)(p.ws + OFF_GU_) + (size_t)ch * 4096; float* W = (float*)(p.ws + OFF_GW) + (size_t)ch * 4096; float* KD = (float*)(p.ws + OFF_GKD) + (size_t)ch * 4096;
  __syncthreads();
  gdn_gates(p, l, b, hh, s0, sG, sBeta);
  gdn_conv(p, l, b, hh, s0, 1, sR + 64, 129, true, 1.f);
  gdn_conv(p, l, b, hh, s0, 2, sR, 129, false, 1.f);
  __syncthreads();
  const float Glast = sG[63], Gc = sG[c], bc = sBeta[c];
  { const float f = expf(Glast - Gc);
#pragma unroll
    for (int d = 0; d < 16; ++d) KD[c * 64 + part * 16 + d] = sR[c * 129 + 64 + part * 16 + d] * f; }
  for (int i = 0; i < 16; ++i) { const int s = part + 4 * i; float a = 0.f;
    if (s < c) { float dot = 0.f;
#pragma unroll 16
      for (int d = 0; d < 64; ++d) dot += sR[c * 129 + 64 + d] * sR[s * 129 + 64 + d];
      a = bc * dot * expf(Gc - sG[s]); }
    sA[c * 64 + s] = a; }
  __syncthreads();
  { const float f2 = bc * expf(Gc);
#pragma unroll
    for (int d = 0; d < 16; ++d) { sR[c * 129 + part * 16 + d] *= bc; sR[c * 129 + 64 + part * 16 + d] *= f2; } }
  __syncthreads();
  if (tid < 128) {
    float sol[64];
#pragma unroll
    for (int cc = 0; cc < 64; ++cc) sol[cc] = sR[cc * 129 + tid];
#pragma unroll
    for (int cc = 1; cc < 64; ++cc) { float a0 = 0.f, a1 = 0.f;
#pragma unroll
      for (int s2 = 0; s2 < cc; ++s2) { if (s2 & 1) a1 += sA[cc * 64 + s2] * sol[s2]; else a0 += sA[cc * 64 + s2] * sol[s2]; }
      sol[cc] -= a0 + a1; }
#pragma unroll
    for (int cc = 1; cc < 64; ++cc) sR[cc * 129 + tid] = sol[cc];
  }
  __syncthreads();
#pragma unroll
  for (int d = 0; d < 16; ++d) { U[c * 64 + part * 16 + d] = sR[c * 129 + part * 16 + d]; W[c * 64 + part * 16 + d] = sR[c * 129 + 64 + part * 16 + d]; }
  if (tid == 0) ((float*)(p.ws + OFF_GLAST))[ch] = expf(Glast);
}
DI void m0_phase(const Params& p, int l, char* smem) {
  if (blockIdx.x == 0 && tid_() < 64) ((unsigned*)(p.ws + OFF_CNT))[tid_()] = 0u;
  for (int it = blockIdx.x; it < 2560 + 1024; it += gridDim.x) {
    if (it < 1024) gdn_g1(p, l, it, smem); else vt_tile(p, it - 1024, smem);
  }
}

struct KVRegs { u32x4 k[2], v[2]; };
DI void kv_wait(KVRegs& rg) { asm volatile("s_waitcnt vmcnt(0)" : "+v"(rg.k[0]), "+v"(rg.k[1]), "+v"(rg.v[0]), "+v"(rg.v[1]) :: "memory"); }
template <int DQK> DI void kv_issue(const bf16_t* Kb, const bf16_t* Vt, int k0, KVRegs& rg) {
  const int tid = tid_();
  if (DQK == 64) {
#pragma unroll
    for (int q = 0; q < 2; ++q) { const int idx = tid + 256 * q, key = idx >> 3, c = idx & 7; rg.k[q] = gldv(Kb + (size_t)(k0 + key) * LDP + c * 8); }
  } else { const int key = tid >> 2, c = tid & 3; rg.k[0] = gldv(Kb + (size_t)(k0 + key) * LDP + c * 8); }
#pragma unroll
  for (int q = 0; q < 2; ++q) { const int idx = tid + 256 * q, dv = idx >> 3, c = idx & 7; rg.v[q] = gldv(Vt + (size_t)dv * VLD + k0 + c * 8); }
}
template <int DQK> DI void kv_commit(const KVRegs& rg, bf16_t* sK, bf16_t* sV) {
  constexpr int LDK = DQK + 8; const int tid = tid_();
  if (DQK == 64) {
#pragma unroll
    for (int q = 0; q < 2; ++q) { const int idx = tid + 256 * q, key = idx >> 3, c = idx & 7; *(u32x4*)(sK + key * LDK + c * 8) = rg.k[q]; }
  } else { const int key = tid >> 2, c = tid & 3; *(u32x4*)(sK + key * LDK + c * 8) = rg.k[0]; }
#pragma unroll
  for (int q = 0; q < 2; ++q) { const int idx = tid + 256 * q, dv = idx >> 3, c = idx & 7; const u32x4 v = rg.v[q];
    uint2* d = (uint2*)(sV + dv * 68 + c * 8); d[0] = (uint2){v[0], v[1]}; d[1] = (uint2){v[2], v[3]}; }
}
DI bf16x8 pack8(const f32x16& x, int s) {
  bf16x8 r;
#pragma unroll
  for (int j = 0; j < 8; ++j) r[j] = (short)f2bf(x[8 * s + j]);
  return r;
}
DI void pv_accum(const f32x16 (&s)[2], const bf16_t* sV, int r, int h, f32x16 (&O)[2]) {
#pragma unroll
  for (int t2 = 0; t2 < 2; ++t2)
#pragma unroll
    for (int s2 = 0; s2 < 2; ++s2) {
      const bf16x8 pf = pack8(s[t2], s2);
#pragma unroll
      for (int dt = 0; dt < 2; ++dt) {
        const bf16_t* vp = sV + (dt * 32 + r) * 68 + t2 * 32 + 16 * s2 + 4 * h;
        const s16x4 lo = *(const s16x4*)vp, hi = *(const s16x4*)(vp + 8);
        const bf16x8 vf = __builtin_shufflevector(lo, hi, 0, 1, 2, 3, 4, 5, 6, 7);
        O[dt] = MFMA32(vf, pf, O[dt]);
      }
    }
}
template <int DQK>
DI void attn_tile_step(const bf16_t* sK, const bf16_t* sV, const bf16x8 (&qf)[DQK / 16], int k0, int qpos, int window, float sl2, float& m, float& lsum, f32x16 (&O)[2], int r, int h) {
  constexpr int NKS = DQK / 16, LDK = DQK + 8;
  f32x16 s[2];
#pragma unroll
  for (int t2 = 0; t2 < 2; ++t2) {
#pragma unroll
    for (int i = 0; i < 16; ++i) s[t2][i] = 0.f;
#pragma unroll
    for (int ks = 0; ks < NKS; ++ks) { const bf16x8 a = *(const bf16x8*)(sK + (t2 * 32 + r) * LDK + ks * 16 + 8 * h); s[t2] = MFMA32(a, qf[ks], s[t2]); }
  }
  float mx = m;
#pragma unroll
  for (int t2 = 0; t2 < 2; ++t2)
#pragma unroll
    for (int i = 0; i < 16; ++i) { const int kpos = k0 + t2 * 32 + crow(i, h); const bool ok = (kpos <= qpos) && (window == 0 || qpos - kpos < window);
      const float v = ok ? s[t2][i] * sl2 : -1e30f; s[t2][i] = v; mx = fmaxf(mx, v); }
  mx = fmaxf(mx, __shfl_xor(mx, 32));
  const float corr = fexp2(m - mx); m = mx; float ps = 0.f;
#pragma unroll
  for (int t2 = 0; t2 < 2; ++t2)
#pragma unroll
    for (int i = 0; i < 16; ++i) { const float pv = (s[t2][i] > -1e29f) ? fexp2(s[t2][i] - mx) : 0.f; s[t2][i] = pv; ps += pv; }
  lsum = lsum * corr + ps;
#pragma unroll
  for (int dt = 0; dt < 2; ++dt)
#pragma unroll
    for (int i = 0; i < 16; ++i) O[dt][i] *= corr;
  pv_accum(s, sV, r, h, O);
}
DI void o_zero(f32x16 (&O)[2]) {
#pragma unroll
  for (int dt = 0; dt < 2; ++dt)
#pragma unroll
    for (int i = 0; i < 16; ++i) O[dt][i] = 0.f;
}
DI void o_finish(f32x16 (&O)[2], float lsum) {
  lsum += __shfl_xor(lsum, 32);
  const float inv = 1.f / lsum;
#pragma unroll
  for (int dt = 0; dt < 2; ++dt)
#pragma unroll
    for (int i = 0; i < 16; ++i) O[dt][i] *= inv;
}
DI void store_o(const f32x16 (&O)[2], bf16_t* dst  , int h) {
#pragma unroll
  for (int dt = 0; dt < 2; ++dt)
#pragma unroll
    for (int g = 0; g < 4; ++g) { uint2 pk; pk.x = pack2(O[dt][4 * g], O[dt][4 * g + 1]); pk.y = pack2(O[dt][4 * g + 2], O[dt][4 * g + 3]); *(uint2*)(dst + dt * 32 + 8 * g + 4 * h) = pk; }
}
DI void diff_item(const Params& p, int l, int b, int hh, int qb, char* smem) {
  const bf16_t* proj = (const bf16_t*)(p.ws + OFF_BIG) + (size_t)(b * S_) * LDP;
  const bf16_t* vt = (const bf16_t*)(p.ws + OFF_VT) + (size_t)(hh * 64) * VLD + b * S_;
  const int q0 = qb * 128, tid = tid_(), lane = tid & 63, wave = tid >> 6, r = lane & 31, h = lane >> 5, qw0 = q0 + wave * 32, qpos = qw0 + r;
  bf16_t* sK1 = (bf16_t*)smem; bf16_t* sK2 = sK1 + 64 * 40; bf16_t* sV = sK2 + 64 * 40;
  float d1 = 0.f, d2 = 0.f;
  for (int i = 0; i < 32; ++i) { d1 += p.lq1[l * 32 + i] * p.lk1[l * 32 + i]; d2 += p.lq2[l * 32 + i] * p.lk2[l * 32 + i]; }
  asm volatile("" : "+v"(d1), "+v"(d2));
  const float lam_init = 0.8f - 0.6f * expf(-0.3f * (float)l), lam = expf(d1) - expf(d2) + lam_init;
  const float sl2 = 0.17677669529663687f * 1.4426950408889634f;
  bf16x8 qf1[2], qf2[2];
#pragma unroll
  for (int ks = 0; ks < 2; ++ks) { qf1[ks] = *(const bf16x8*)(proj + (size_t)qpos * LDP + C_DQ1 + hh * 32 + ks * 16 + 8 * h); qf2[ks] = *(const bf16x8*)(proj + (size_t)qpos * LDP + C_DQ2 + hh * 32 + ks * 16 + 8 * h); }
  f32x16 O1[2], O2[2]; o_zero(O1); o_zero(O2);
  float m1 = -1e30f, m2 = -1e30f, l1 = 0.f, l2 = 0.f;
  const int kt1 = (q0 + 128) >> 6;
  const bf16_t* K1g = proj + C_DK1 + hh * 32; const bf16_t* K2g = proj + C_DK2 + hh * 32;
  KVRegs rg; rg.k[1] = (u32x4){0u, 0u, 0u, 0u}; uint4 rk2;
  kv_issue<32>(K1g, vt, 0, rg); rk2 = gld16(K2g + (size_t)(tid >> 2) * LDP + (tid & 3) * 8);
#pragma unroll 1
  for (int kt = 0; kt < kt1; ++kt) {
    const int k0 = kt * 64;
    kv_wait(rg); vm_wait0();
    __syncthreads();
    kv_commit<32>(rg, sK1, sV); *(uint4*)(sK2 + (tid >> 2) * 40 + (tid & 3) * 8) = rk2;
    __syncthreads();
    { const int kn = (kt + 1 < kt1 ? kt + 1 : kt) * 64; kv_issue<32>(K1g, vt, kn, rg); rk2 = gld16(K2g + (size_t)(kn + (tid >> 2)) * LDP + (tid & 3) * 8); }
    if (k0 > qw0 + 31) continue;
    attn_tile_step<32>(sK1, sV, qf1, k0, qpos, 0, sl2, m1, l1, O1, r, h);
    __builtin_amdgcn_sched_barrier(0);
    attn_tile_step<32>(sK2, sV, qf2, k0, qpos, 0, sl2, m2, l2, O2, r, h);
    __builtin_amdgcn_sched_barrier(0);
  }
  vm_wait0();
  o_finish(O1, l1); o_finish(O2, l2);
  float ss = 0.f;
#pragma unroll
  for (int dt = 0; dt < 2; ++dt)
#pragma unroll
    for (int i = 0; i < 16; ++i) { const float o = O1[dt][i] - lam * O2[dt][i]; O1[dt][i] = o; ss += o * o; }
  ss += __shfl_xor(ss, 32);
  const float rn = rsqrtf(ss * (1.f / 64.f) + 1e-6f) * (1.f - lam_init);
  int goff = l * 64 + 4 * h; asm volatile("" : "+v"(goff));
#pragma unroll
  for (int dt = 0; dt < 2; ++dt)
#pragma unroll
    for (int g = 0; g < 4; ++g) { const float4 gg = *(const float4*)(p.subln + goff + dt * 32 + 8 * g);
      O1[dt][4 * g] *= rn * gg.x; O1[dt][4 * g + 1] *= rn * gg.y; O1[dt][4 * g + 2] *= rn * gg.z; O1[dt][4 * g + 3] *= rn * gg.w; }
  bf16_t* mix = (bf16_t*)(p.ws + OFF_XB);
  store_o(O1, mix + (size_t)(b * S_ + qpos) * D_ + hh * 64, h);
}
DI void win_item(const Params& p, int b, int hh, int qb, char* smem) {
  const bf16_t* proj = (const bf16_t*)(p.ws + OFF_BIG) + (size_t)(b * S_) * LDP;
  const bf16_t* vt = (const bf16_t*)(p.ws + OFF_VT) + (size_t)(8 * 64) * VLD + b * S_;
  const int q0 = qb * 128, lane = tid_() & 63, wave = tid_() >> 6, r = lane & 31, h = lane >> 5, qw0 = q0 + wave * 32, qpos = qw0 + r;
  bf16_t* sK = (bf16_t*)smem; bf16_t* sV = sK + 64 * 72;
  int kt0 = (q0 >> 6) - 8; if (kt0 < 0) kt0 = 0;
  bf16x8 qf[4];
#pragma unroll
  for (int ks = 0; ks < 4; ++ks) qf[ks] = *(const bf16x8*)(proj + (size_t)qpos * LDP + C_NQ + hh * 64 + ks * 16 + 8 * h);
  f32x16 O[2]; o_zero(O);
  float m = -1e30f, lsum = 0.f;
  const int kt1 = (q0 + 128) >> 6;
  KVRegs rg; kv_issue<64>(proj + C_NKW, vt, kt0 * 64, rg);
#pragma unroll 1
  for (int kt = kt0; kt < kt1; ++kt) {
    const int k0 = kt * 64;
    kv_wait(rg);
    __syncthreads();
    kv_commit<64>(rg, sK, sV);
    __syncthreads();
    kv_issue<64>(proj + C_NKW, vt, (kt + 1 < kt1 ? kt + 1 : kt) * 64, rg);
    if (k0 > qw0 + 31) continue;
    if (k0 + 63 < qw0 - 511) continue;
    attn_tile_step<64>(sK, sV, qf, k0, qpos, 512, 0.125f * 1.4426950408889634f, m, lsum, O, r, h);
  }
  vm_wait0();
  o_finish(O, lsum);
  bf16_t* ow = (bf16_t*)(p.ws + OFF_OWIN);
  store_o(O, ow + (size_t)(b * S_ + qpos) * 256 + hh * 64, h);
}
DI void sb_item(const Params& p, int b, int hh, int qb, char* smem) {
  const bf16_t* proj = (const bf16_t*)(p.ws + OFF_BIG) + (size_t)(b * S_) * LDP;
  const bf16_t* Qb = proj + C_SQ + hh * 64; const bf16_t* Kb = proj + C_SK + hh * 64;
  const bf16_t* Vt = (const bf16_t*)(p.ws + OFF_VT) + (size_t)((4 + hh) * 64) * VLD + b * S_;
  bf16_t* sK = (bf16_t*)smem; bf16_t* sV = sK + 64 * 72;
  const int q0 = qb * 128, lane = tid_() & 63, wave = tid_() >> 6, r = lane & 31, h = lane >> 5;
  const int qw0 = q0 + wave * 32, qpos = qw0 + r;
  bf16x8 qf[4];
#pragma unroll
  for (int ks = 0; ks < 4; ++ks) qf[ks] = *(const bf16x8*)(Qb + (size_t)qpos * LDP + ks * 16 + 8 * h);
  f32x16 O[2];
#pragma unroll
  for (int dt = 0; dt < 2; ++dt)
#pragma unroll
    for (int i = 0; i < 16; ++i) O[dt][i] = 0.f;
  float R = 0.f;
  float* sflag = (float*)(smem + 20480);
  if (tid_() < 4) sflag[tid_()] = 0.f;
  KVRegs rg; kv_issue<64>(Kb, Vt, ((q0 + 127) >> 6) * 64, rg);
#pragma unroll 1
  for (int kt = (q0 + 127) >> 6; kt >= 0; --kt) {
    const int k0 = kt * 64;
    kv_wait(rg);
    __syncthreads();
    const float rmin = fminf(fminf(sflag[0], sflag[1]), fminf(sflag[2], sflag[3]));
    if (rmin > 90.f) break;
    kv_commit<64>(rg, sK, sV);
    __syncthreads();
    kv_issue<64>(Kb, Vt, (kt > 0 ? kt - 1 : 0) * 64, rg);
    if (k0 >= qw0 + 31) continue;
    { const float wmin = -wave_max(-R); if (wmin > 90.f) continue; }
    f32x16 s[2];
#pragma unroll
    for (int t2 = 0; t2 < 2; ++t2) {
#pragma unroll
      for (int i = 0; i < 16; ++i) s[t2][i] = 0.f;
#pragma unroll
      for (int ks = 0; ks < 4; ++ks) { const bf16x8 a = *(const bf16x8*)(sK + (t2 * 32 + r) * 72 + ks * 16 + 8 * h); s[t2] = MFMA32(a, qf[ks], s[t2]); }
    }
    float Tt = 0.f;
#pragma unroll
    for (int t2 = 1; t2 >= 0; --t2)
#pragma unroll
      for (int g = 3; g >= 0; --g) {
        float z[4], sp[4]; bool ok[4]; float gs = 0.f;
#pragma unroll
        for (int e = 0; e < 4; ++e) { const int kpos = k0 + t2 * 32 + 8 * g + 4 * h + e; ok[e] = kpos < qpos; z[e] = s[t2][4 * g + e] * 0.125f;
          const float spv = fmaxf(z[e], 0.f) + flog(1.f + fexp(-fabsf(z[e]))); sp[e] = ok[e] ? spv : 0.f; gs += sp[e]; }
        const float pg = __shfl_xor(gs, 32);
        float run = R + Tt + (h == 0 ? pg : 0.f);
#pragma unroll
        for (int e = 3; e >= 0; --e) { run += sp[e]; s[t2][4 * g + e] = ok[e] ? fexp(z[e] - run) : 0.f; }
        Tt += gs + pg;
      }
    R += Tt;
    { const float wmin = -wave_max(-R); if (lane == 0) sflag[wave] = wmin; }
    pv_accum(s, sV, r, h, O);
  }
  vm_wait0();
  bf16_t* mix = (bf16_t*)(p.ws + OFF_XB);
  store_o(O, mix + (size_t)(b * S_ + qpos) * D_ + 768 + hh * 64, h);
}

DI void gdn_chain(const Params& p, int item, char* smem) {
  const int b = item >> 4, hh = (item >> 2) & 3, sl = item & 3, tid = tid_(), c = tid >> 2, e4 = (tid & 3) * 4;
  float* sW = (float*)smem; float* sKD = sW + 64 * 65; float* sS = sKD + 64 * 65; float* sV = sS + 1024; float* sU = sV + 1024;
  float* U = (float*)(p.ws + OFF_GU_); const float* W = (const float*)(p.ws + OFF_GW); const float* KD = (const float*)(p.ws + OFF_GKD);
  float* Sg = (float*)(p.ws + OFF_GS); const float* glast = (const float*)(p.ws + OFF_GLAST);
  const int ch0 = (b * 4 + hh) * 128;
  __syncthreads();
  *(float4*)(sS + tid * 4) = (float4){0.f, 0.f, 0.f, 0.f};
  float4 rw[4], rk[4], ru;
  { const float4* wp = (const float4*)(W + (size_t)ch0 * 4096); const float4* kp = (const float4*)(KD + (size_t)ch0 * 4096);
#pragma unroll
    for (int i = 0; i < 4; ++i) { rw[i] = gldf4(wp + tid + 256 * i); rk[i] = gldf4(kp + tid + 256 * i); }
    ru = gldf4(U + (size_t)ch0 * 4096 + c * 64 + sl * 16 + e4); }
  for (int n = 0; n < 128; ++n) {
    const int ch = ch0 + n;
    vm_wait0();
    __syncthreads();
#pragma unroll
    for (int i = 0; i < 4; ++i) { const int idx = (tid + 256 * i) * 4, rr = idx >> 6, cc = idx & 63;
      float* dw = sW + rr * 65 + cc; dw[0] = rw[i].x; dw[1] = rw[i].y; dw[2] = rw[i].z; dw[3] = rw[i].w;
      float* dk = sKD + rr * 65 + cc; dk[0] = rk[i].x; dk[1] = rk[i].y; dk[2] = rk[i].z; dk[3] = rk[i].w; }
    *(float4*)(sU + c * 16 + e4) = ru;
    const float gl = glast[ch];
    __syncthreads();
    if (n + 1 < 128) { const float4* wp = (const float4*)(W + (size_t)(ch + 1) * 4096); const float4* kp = (const float4*)(KD + (size_t)(ch + 1) * 4096);
#pragma unroll
      for (int i = 0; i < 4; ++i) { rw[i] = gldf4(wp + tid + 256 * i); rk[i] = gldf4(kp + tid + 256 * i); }
      ru = gldf4(U + (size_t)(ch + 1) * 4096 + c * 64 + sl * 16 + e4); }
    float4 acc = *(const float4*)(sU + c * 16 + e4);
#pragma unroll 8
    for (int d = 0; d < 64; ++d) { const float wv = sW[c * 65 + d]; const float4 sv = *(const float4*)(sS + d * 16 + e4);
      acc.x -= wv * sv.x; acc.y -= wv * sv.y; acc.z -= wv * sv.z; acc.w -= wv * sv.w; }
    *(float4*)(sV + c * 16 + e4) = acc;
    *(float4*)(U + (size_t)ch * 4096 + c * 64 + sl * 16 + e4) = acc;
    float4 sold = *(const float4*)(sS + c * 16 + e4);
    *(float4*)(Sg + (size_t)ch * 4096 + c * 64 + sl * 16 + e4) = sold;
    __syncthreads();
    sold.x *= gl; sold.y *= gl; sold.z *= gl; sold.w *= gl;
#pragma unroll 8
    for (int cc = 0; cc < 64; ++cc) { const float kv = sKD[cc * 65 + c]; const float4 vv = *(const float4*)(sV + cc * 16 + e4);
      sold.x += kv * vv.x; sold.y += kv * vv.y; sold.z += kv * vv.z; sold.w += kv * vv.w; }
    *(float4*)(sS + c * 16 + e4) = sold;
  }
}
DI void gdn_g3(const Params& p, int l, int ch, char* smem) {
  const int b = ch >> 9, hh = (ch >> 7) & 3, n = ch & 127, s0 = n * 64, tid = tid_(), c = tid >> 2, part = tid & 3;
  float* B1 = (float*)smem; float* B2 = B1 + 64 * 68; float* B3 = B2 + 64 * 68; float* sG = B3 + 64 * 68; float* sBeta = sG + 64;
  const float* Vn = (const float*)(p.ws + OFF_GU_) + (size_t)ch * 4096; const float* Sg = (const float*)(p.ws + OFF_GS) + (size_t)ch * 4096;
  __syncthreads();
  gdn_gates(p, l, b, hh, s0, sG, sBeta);
  gdn_conv(p, l, b, hh, s0, 0, B1, 68, true, 0.125f);
  gdn_conv(p, l, b, hh, s0, 1, B2, 68, true, 1.f);
  __syncthreads();
  const float Gc = sG[c];
  for (int i = 0; i < 16; ++i) { const int s = part + 4 * i; float a = 0.f;
    if (s <= c) { float dot = 0.f;
#pragma unroll
      for (int d4 = 0; d4 < 16; ++d4) { const float4 x = *(const float4*)(B1 + c * 68 + 4 * d4), y = *(const float4*)(B2 + s * 68 + 4 * d4); dot += (x.x * y.x + x.y * y.y) + (x.z * y.z + x.w * y.w); }
      a = dot * expf(Gc - sG[s]); }
    B3[c * 68 + s] = a; }
  __syncthreads();
#pragma unroll
  for (int i = 0; i < 4; ++i) { const int idx = (tid + 256 * i) * 4, rr = idx >> 6, cc = idx & 63; const float4 v = *(const float4*)(Sg + idx);
    *(float4*)(B2 + rr * 68 + cc) = v; }
  __syncthreads();
  float acc[16];
#pragma unroll
  for (int e = 0; e < 16; ++e) acc[e] = 0.f;
#pragma unroll 2
  for (int d4 = 0; d4 < 16; ++d4) { const float4 q4 = *(const float4*)(B1 + c * 68 + 4 * d4); const float qv[4] = {q4.x, q4.y, q4.z, q4.w};
#pragma unroll
    for (int dd = 0; dd < 4; ++dd)
#pragma unroll
      for (int e4 = 0; e4 < 4; ++e4) { const float4 bv = *(const float4*)(B2 + (4 * d4 + dd) * 68 + part * 16 + 4 * e4);
        acc[4 * e4] += qv[dd] * bv.x; acc[4 * e4 + 1] += qv[dd] * bv.y; acc[4 * e4 + 2] += qv[dd] * bv.z; acc[4 * e4 + 3] += qv[dd] * bv.w; } }
  { const float eg = expf(Gc);
#pragma unroll
    for (int e = 0; e < 16; ++e) acc[e] *= eg; }
  __syncthreads();
#pragma unroll
  for (int i = 0; i < 4; ++i) { const int idx = (tid + 256 * i) * 4, rr = idx >> 6, cc = idx & 63; const float4 v = *(const float4*)(Vn + idx);
    *(float4*)(B2 + rr * 68 + cc) = v; }
  __syncthreads();
#pragma unroll 2
  for (int s4 = 0; s4 < 16; ++s4) { const float4 i4 = *(const float4*)(B3 + c * 68 + 4 * s4); const float iv[4] = {i4.x, i4.y, i4.z, i4.w};
#pragma unroll
    for (int dd = 0; dd < 4; ++dd)
#pragma unroll
      for (int e4 = 0; e4 < 4; ++e4) { const float4 bv = *(const float4*)(B2 + (4 * s4 + dd) * 68 + part * 16 + 4 * e4);
        acc[4 * e4] += iv[dd] * bv.x; acc[4 * e4 + 1] += iv[dd] * bv.y; acc[4 * e4 + 2] += iv[dd] * bv.z; acc[4 * e4 + 3] += iv[dd] * bv.w; } }
  float ss = 0.f;
#pragma unroll
  for (int e = 0; e < 16; ++e) ss += acc[e] * acc[e];
  ss += __shfl_xor(ss, 1); ss += __shfl_xor(ss, 2);
  const float rn = rsqrtf(ss * (1.f / 64.f) + 1e-6f);
  const size_t tok = (size_t)(b * S_ + s0 + c);
  const bf16_t* zr = (const bf16_t*)(p.ws + OFF_BIG) + tok * LDP + C_GZ + hh * 64 + part * 16;
  bf16_t* mix = (bf16_t*)(p.ws + OFF_XB) + tok * D_ + 256 + hh * 64 + part * 16;
#pragma unroll
  for (int e = 0; e < 16; e += 2) {
    const float z0 = bf2f(zr[e]), z1 = bf2f(zr[e + 1]);
    const float y0 = acc[e] * rn * p.gdng[l * 64 + part * 16 + e] * (z0 / (1.f + __expf(-z0)));
    const float y1 = acc[e + 1] * rn * p.gdng[l * 64 + part * 16 + e + 1] * (z1 / (1.f + __expf(-z1)));
    *(unsigned*)(mix + e) = pack2(y0, y1);
  }
}

DI void nsa_compress(const Params& p, int l, int item, char* smem) {
  const int b = item >> 7, kv = (item >> 6) & 1, grp = item & 63, c0 = grp * 8, tok0 = c0 * 16, tid = tid_(), lane = tid & 63, wv = tid >> 6;
  const bf16_t* proj = (const bf16_t*)(p.ws + OFF_BIG) + (size_t)(b * S_) * LDP + (kv ? C_NVC : C_NKC);
  bf16_t* X = (bf16_t*)smem;
  float* Hp = (float*)(smem + 18432);
  __syncthreads();
  for (int idx = tid; idx < 144 * 8; idx += 256) { const int tk = idx >> 3, c = idx & 7, si = tok0 + tk;
    uint4 v = {0u, 0u, 0u, 0u}; if (si < S_) v = *(const uint4*)(proj + (size_t)si * LDP + c * 8);
    *(uint4*)(X + tk * 64 + c * 8) = v; }
  __syncthreads();
  const float* w1 = (kv ? p.cvw1 : p.ckw1) + (size_t)l * 2048 * 256 + lane * 4; const float* pe = (kv ? p.pev : p.pek) + (size_t)l * 2048;
  float acc[8][4], bias[4] = {0.f, 0.f, 0.f, 0.f};
#pragma unroll
  for (int r = 0; r < 8; ++r) { acc[r][0] = 0.f; acc[r][1] = 0.f; acc[r][2] = 0.f; acc[r][3] = 0.f; }
  const int i0 = wv * 512;
  for (int ib = 0; ib < 512; ib += 8) {
    f32x4 wr[8];
#pragma unroll
    for (int u = 0; u < 8; ++u) wr[u] = gldfv(w1 + (size_t)(i0 + ib + u) * 256);
    asm volatile("s_waitcnt vmcnt(0)" : "+v"(wr[0]), "+v"(wr[1]), "+v"(wr[2]), "+v"(wr[3]), "+v"(wr[4]), "+v"(wr[5]), "+v"(wr[6]), "+v"(wr[7]) :: "memory");
#pragma unroll
    for (int u = 0; u < 8; ++u) { const int i = i0 + ib + u, tk = i >> 6, d = i & 63; const float pv = pe[i]; const f32x4 w = wr[u];
      bias[0] += pv * w[0]; bias[1] += pv * w[1]; bias[2] += pv * w[2]; bias[3] += pv * w[3];
#pragma unroll
      for (int r = 0; r < 8; ++r) { const float xv = bf2f(X[(16 * r + tk) * 64 + d]); acc[r][0] += xv * w[0]; acc[r][1] += xv * w[1]; acc[r][2] += xv * w[2]; acc[r][3] += xv * w[3]; } }
  }
#pragma unroll
  for (int r = 0; r < 8; ++r) *(float4*)(Hp + (wv * 8 + r) * 256 + lane * 4) = (float4){acc[r][0] + bias[0], acc[r][1] + bias[1], acc[r][2] + bias[2], acc[r][3] + bias[3]};
  __syncthreads();
#pragma unroll
  for (int q = 0; q < 8; ++q) { const int idx = tid + 256 * q; const float hv = Hp[idx] + Hp[2048 + idx] + Hp[4096 + idx] + Hp[6144 + idx]; Hp[idx] = hv / (1.f + __expf(-hv)); }
  __syncthreads();
  const float* H = Hp;
  const float* w2 = (kv ? p.cvw2 : p.ckw2) + (size_t)l * 256 * 64;
  const int r0 = tid >> 6, d = tid & 63; float o0 = 0.f, o1 = 0.f;
  for (int jb = 0; jb < 256; jb += 16) { float w[16];
#pragma unroll
    for (int u = 0; u < 16; ++u) w[u] = gld32(w2 + (jb + u) * 64 + d);
    asm volatile("s_waitcnt vmcnt(0)" : "+v"(w[0]), "+v"(w[1]), "+v"(w[2]), "+v"(w[3]), "+v"(w[4]), "+v"(w[5]), "+v"(w[6]), "+v"(w[7]), "+v"(w[8]), "+v"(w[9]), "+v"(w[10]), "+v"(w[11]), "+v"(w[12]), "+v"(w[13]), "+v"(w[14]), "+v"(w[15]) :: "memory");
#pragma unroll
    for (int u = 0; u < 16; ++u) { o0 += H[r0 * 256 + jb + u] * w[u]; o1 += H[(r0 + 4) * 256 + jb + u] * w[u]; } }
  bf16_t* dst = (bf16_t*)(p.ws + (kv ? OFF_VCMP : OFF_KCMP)) + (size_t)b * (kv ? 64 * CLD : 512 * 64);
  { const int c1 = c0 + r0, c2 = c0 + r0 + 4; const float v1 = c1 < 511 ? o0 : 0.f, v2 = c2 < 511 ? o1 : 0.f;
    if (kv) { dst[d * CLD + c1] = f2bf(v1); dst[d * CLD + c2] = f2bf(v2); } else { dst[c1 * 64 + d] = f2bf(v1); dst[c2 * 64 + d] = f2bf(v2); } }
}
struct SelRegs { u32x4 ka[2], kb[2], v[4]; };
DI void sel_issue(SelRegs& rg, const bf16_t* kbase  , int kld, const bf16_t* vtbase  , int vld, int rowa, int l15, int quad) {
#pragma unroll
  for (int ks = 0; ks < 2; ++ks) { rg.ka[ks] = gldv(kbase + (size_t)rowa * kld + ks * 32 + quad * 8); rg.kb[ks] = gldv(kbase + (size_t)(rowa + 4) * kld + ks * 32 + quad * 8); }
#pragma unroll
  for (int dt = 0; dt < 4; ++dt) rg.v[dt] = gldv(vtbase + (size_t)(dt * 16 + l15) * vld + 8 * quad);
}
DI void sel_wait(SelRegs& rg) {
  asm volatile("s_waitcnt vmcnt(0)" : "+v"(rg.ka[0]), "+v"(rg.ka[1]), "+v"(rg.kb[0]), "+v"(rg.kb[1]), "+v"(rg.v[0]), "+v"(rg.v[1]), "+v"(rg.v[2]), "+v"(rg.v[3]) :: "memory");
}
DI void sel_compute(const SelRegs& rg, const bf16x8 (&qf)[2], int kb0, bool colsel, int stk, int quad, float& m, float& lsum, f32x4 (&Os)[4]) {
  f32x4 sa = {0.f, 0.f, 0.f, 0.f}, sb = {0.f, 0.f, 0.f, 0.f};
#pragma unroll
  for (int ks = 0; ks < 2; ++ks) { sa = MFMA16(__builtin_bit_cast(bf16x8, rg.ka[ks]), qf[ks], sa); sb = MFMA16(__builtin_bit_cast(bf16x8, rg.kb[ks]), qf[ks], sb); }
  float mx = m;
#pragma unroll
  for (int i = 0; i < 4; ++i) { const int ka = kb0 + 8 * quad + i;
    const float va = (colsel && ka <= stk) ? sa[i] * 0.125f : -1e30f, vb = (colsel && ka + 4 <= stk) ? sb[i] * 0.125f : -1e30f;
    sa[i] = va; sb[i] = vb; mx = fmaxf(mx, fmaxf(va, vb)); }
  mx = fmaxf(mx, __shfl_xor(mx, 16)); mx = fmaxf(mx, __shfl_xor(mx, 32));
  const float corr = fexp(m - mx); m = mx; float ps = 0.f;
#pragma unroll
  for (int i = 0; i < 4; ++i) { const float pa = sa[i] > -1e29f ? fexp(sa[i] - mx) : 0.f, pb = sb[i] > -1e29f ? fexp(sb[i] - mx) : 0.f; sa[i] = pa; sb[i] = pb; ps += pa + pb; }
  lsum = lsum * corr + ps;
  bf16x8 pf;
#pragma unroll
  for (int i = 0; i < 4; ++i) { pf[i] = (short)f2bf(sa[i]); pf[4 + i] = (short)f2bf(sb[i]); }
#pragma unroll
  for (int dt = 0; dt < 4; ++dt) { Os[dt][0] *= corr; Os[dt][1] *= corr; Os[dt][2] *= corr; Os[dt][3] *= corr; Os[dt] = MFMA16(__builtin_bit_cast(bf16x8, rg.v[dt]), pf, Os[dt]); }
}
DI void nsa_group(const Params& p, int t0, float* wl) {
  const int lane = tid_() & 63, l15 = lane & 15, quad = lane >> 4, tk = l15 >> 2, hd = l15 & 3;
  const int b = t0 >> 13, s0 = t0 & (S_ - 1), cur = s0 >> 6, stk = s0 + tk;
  const bf16_t* projb = (const bf16_t*)(p.ws + OFF_BIG) + (size_t)(b * S_) * LDP;
  const bf16_t* kc = (const bf16_t*)(p.ws + OFF_KCMP) + (size_t)b * 512 * 64; const bf16_t* vcT = (const bf16_t*)(p.ws + OFF_VCMP) + (size_t)b * 64 * CLD;
  const bf16_t* vsT = (const bf16_t*)(p.ws + OFF_VT) + (size_t)(9 * 64) * VLD + b * S_;
  float* Gs = wl; float* Cs = wl + 4 * 132; int* blist = (int*)(wl + 8 * 132);
  WAVE_SYNC();
  for (int i = lane; i < 8 * 132; i += 64) wl[i] = 0.f;
  bf16x8 qf[2];
#pragma unroll
  for (int ks = 0; ks < 2; ++ks) qf[ks] = *(const bf16x8*)(projb + (size_t)stk * LDP + C_NQ + hd * 64 + ks * 32 + quad * 8);
  const int ncv = stk >= 31 ? ((stk - 31) >> 4) + 1 : 0, ncvmax = (s0 + 3 >= 31) ? ((s0 + 3 - 31) >> 4) + 1 : 0, nstep = (ncvmax + 31) >> 5;
  const int rowa = (l15 >> 2) * 8 + (l15 & 3);
  float m = -1e30f, lsum = 0.f;
  SelRegs c0r, c1r;
  f32x4 Oc[4];
#pragma unroll
  for (int dt = 0; dt < 4; ++dt) Oc[dt] = (f32x4){0.f, 0.f, 0.f, 0.f};
#define CMP_SCORES(rg_, cbase_) \
    f32x4 sa = {0.f, 0.f, 0.f, 0.f}, sb = {0.f, 0.f, 0.f, 0.f}; \
    _Pragma("unroll") for (int ks = 0; ks < 2; ++ks) { sa = MFMA16(__builtin_bit_cast(bf16x8, rg_.ka[ks]), qf[ks], sa); sb = MFMA16(__builtin_bit_cast(bf16x8, rg_.kb[ks]), qf[ks], sb); }
#define CMP_P1(rg_, cbase_) { CMP_SCORES(rg_, cbase_) float mx = m; \
    _Pragma("unroll") for (int i = 0; i < 4; ++i) { const int ca = (cbase_) + 8 * quad + i; const float va = ca < ncv ? sa[i] * 0.125f : -1e30f, vb = ca + 4 < ncv ? sb[i] * 0.125f : -1e30f; sa[i] = va; sb[i] = vb; mx = fmaxf(mx, fmaxf(va, vb)); } \
    mx = fmaxf(mx, __shfl_xor(mx, 16)); mx = fmaxf(mx, __shfl_xor(mx, 32)); \
    const float corr = fexp(m - mx); m = mx; float ps = 0.f; \
    _Pragma("unroll") for (int i = 0; i < 4; ++i) ps += (sa[i] > -1e29f ? fexp(sa[i] - mx) : 0.f) + (sb[i] > -1e29f ? fexp(sb[i] - mx) : 0.f); \
    lsum = lsum * corr + ps; }
#define CMP_P2(rg_, cbase_) { CMP_SCORES(rg_, cbase_) float ga = 0.f, gb = 0.f; \
    _Pragma("unroll") for (int i = 0; i < 4; ++i) { const int ca = (cbase_) + 8 * quad + i; const float pa = ca < ncv ? fexp(sa[i] * 0.125f - m) * inv : 0.f, pb = ca + 4 < ncv ? fexp(sb[i] * 0.125f - m) * inv : 0.f; \
      sa[i] = pa; sb[i] = pb; ga += pa; gb += pb; } \
    float ca3 = sa[3], cb3 = sb[3]; \
    ga += __shfl_xor(ga, 1); ga += __shfl_xor(ga, 2); gb += __shfl_xor(gb, 1); gb += __shfl_xor(gb, 2); \
    ca3 += __shfl_xor(ca3, 1); ca3 += __shfl_xor(ca3, 2); cb3 += __shfl_xor(cb3, 1); cb3 += __shfl_xor(cb3, 2); \
    if (hd == 0) { const int j = ((cbase_) >> 2) + 2 * quad; Gs[tk * 132 + j] = ga; Gs[tk * 132 + j + 1] = gb; Cs[tk * 132 + j + 1] = ca3; Cs[tk * 132 + j + 2] = cb3; } \
    bf16x8 pf; \
    _Pragma("unroll") for (int i = 0; i < 4; ++i) { pf[i] = (short)f2bf(sa[i]); pf[4 + i] = (short)f2bf(sb[i]); } \
    _Pragma("unroll") for (int dt = 0; dt < 4; ++dt) Oc[dt] = MFMA16(__builtin_bit_cast(bf16x8, rg_.v[dt]), pf, Oc[dt]); }
#define CMP_ISSUE(rg_, st_) sel_issue(rg_, kc + (size_t)((st_) * 32) * 64, 64, vcT + (st_) * 32, CLD, rowa, l15, quad)
  if (nstep > 0) {
    CMP_ISSUE(c0r, 0);
    for (int st = 0; st < nstep; st += 2) {
      sel_wait(c0r); CMP_ISSUE(c1r, (st + 1 < nstep ? st + 1 : st)); CMP_P1(c0r, st * 32)
      sel_wait(c1r); CMP_ISSUE(c0r, (st + 2 < nstep ? st + 2 : 0)); if (st + 1 < nstep) CMP_P1(c1r, (st + 1) * 32)
    }
    sel_wait(c0r);
  }
  lsum += __shfl_xor(lsum, 16); lsum += __shfl_xor(lsum, 32);
  const float inv = lsum > 0.f ? 1.f / lsum : 0.f;
  WAVE_SYNC();
  if (nstep > 0) {
    for (int st = 0; st < nstep; st += 2) {
      sel_wait(c0r); CMP_ISSUE(c1r, (st + 1 < nstep ? st + 1 : st)); CMP_P2(c0r, st * 32)
      sel_wait(c1r); CMP_ISSUE(c0r, (st + 2 < nstep ? st + 2 : st)); if (st + 1 < nstep) CMP_P2(c1r, (st + 1) * 32)
    }
    sel_wait(c0r);
  }
#undef CMP_SCORES
#undef CMP_P1
#undef CMP_P2
#undef CMP_ISSUE
  WAVE_SYNC();
  for (int i = lane; i < 512; i += 64) { const int t2 = i >> 7, j = i & 127; const bool valid = j <= cur, forced = valid && (j == 0 || j == cur || j == cur - 1);
    const float im = Gs[t2 * 132 + j] + Cs[t2 * 132 + j]; Gs[t2 * 132 + j] = forced ? 1e4f : (valid ? im : -1e4f); }
  WAVE_SYNC();
  unsigned long long mlo[4] = {0ull, 0ull, 0ull, 0ull}, mhi[4] = {0ull, 0ull, 0ull, 0ull};
  if (cur < 16) {
#pragma unroll
    for (int t2 = 0; t2 < 4; ++t2) mlo[t2] = (1ull << (cur + 1)) - 1ull;
  } else {
    const int tkr = lane >> 4, sub = lane & 15; float v[8]; int rank[8];
#pragma unroll
    for (int mm = 0; mm < 8; ++mm) { v[mm] = Gs[tkr * 132 + sub + 16 * mm]; rank[mm] = 0; }
#pragma unroll 8
    for (int j2 = 0; j2 <= cur; ++j2) { const float o = Gs[tkr * 132 + j2];
#pragma unroll
      for (int mm = 0; mm < 8; ++mm) rank[mm] += (o > v[mm] || (o == v[mm] && j2 < sub + 16 * mm)) ? 1 : 0; }
#pragma unroll
    for (int mm = 0; mm < 8; ++mm) { const unsigned long long bal = __ballot((sub + 16 * mm <= cur) && rank[mm] < 16);
#pragma unroll
      for (int t2 = 0; t2 < 4; ++t2) { const unsigned long long field = (bal >> (16 * t2)) & 0xffffull; if (mm < 4) mlo[t2] |= field << (16 * mm); else mhi[t2] |= field << (16 * (mm - 4)); } }
  }
  const unsigned long long ulo = mlo[0] | mlo[1] | mlo[2] | mlo[3], uhi = mhi[0] | mhi[1] | mhi[2] | mhi[3];
  const int nlo = __popcll(ulo), nblk = nlo + __popcll(uhi);
  { const unsigned long long below = (1ull << lane) - 1ull;
    if ((ulo >> lane) & 1ull) { int tm = 0;
#pragma unroll
      for (int t2 = 0; t2 < 4; ++t2) tm |= (int)((mlo[t2] >> lane) & 1ull) << t2;
      blist[__popcll(ulo & below)] = lane | (tm << 8); }
    if ((uhi >> lane) & 1ull) { int tm = 0;
#pragma unroll
      for (int t2 = 0; t2 < 4; ++t2) tm |= (int)((mhi[t2] >> lane) & 1ull) << t2;
      blist[nlo + __popcll(uhi & below)] = (lane + 64) | (tm << 8); } }
  WAVE_SYNC();
  float m2 = -1e30f, l2 = 0.f; f32x4 Os[4];
#pragma unroll
  for (int dt = 0; dt < 4; ++dt) Os[dt] = (f32x4){0.f, 0.f, 0.f, 0.f};
  const int nh = 2 * nblk;
  SelRegs r0, r1;
  { const int e0 = __builtin_amdgcn_readfirstlane(blist[0]); sel_issue(r0, projb + (size_t)((e0 & 255) * 64) * LDP + C_NKS, LDP, vsT + (e0 & 255) * 64, VLD, rowa, l15, quad); }
  for (int hs = 0; hs < nh; hs += 2) {
    const int e = __builtin_amdgcn_readfirstlane(blist[hs >> 1]); const int kb0 = (e & 255) * 64; const bool colsel = ((e >> (8 + tk)) & 1) != 0;
    sel_wait(r0);
    sel_issue(r1, projb + (size_t)(kb0 + 32) * LDP + C_NKS, LDP, vsT + kb0 + 32, VLD, rowa, l15, quad);
    sel_compute(r0, qf, kb0, colsel, stk, quad, m2, l2, Os);
    sel_wait(r1);
    { const int en = __builtin_amdgcn_readfirstlane(blist[(hs + 2 < nh ? hs + 2 : hs) >> 1]); sel_issue(r0, projb + (size_t)((en & 255) * 64) * LDP + C_NKS, LDP, vsT + (en & 255) * 64, VLD, rowa, l15, quad); }
    sel_compute(r1, qf, kb0 + 32, colsel, stk, quad, m2, l2, Os);
  }
  sel_wait(r0);
  l2 += __shfl_xor(l2, 16); l2 += __shfl_xor(l2, 32);
  const float inv2 = 1.f / l2;
  const size_t tok = (size_t)(b * S_ + stk);
  const bf16_t* prow = projb + (size_t)stk * LDP;
  const float g0 = 1.f / (1.f + __expf(-bf2f(prow[C_NG + hd * 3]))), g1 = 1.f / (1.f + __expf(-bf2f(prow[C_NG + hd * 3 + 1]))), g2 = 1.f / (1.f + __expf(-bf2f(prow[C_NG + hd * 3 + 2])));
  const bf16_t* ow = (const bf16_t*)(p.ws + OFF_OWIN) + tok * 256 + hd * 64; bf16_t* mix = (bf16_t*)(p.ws + OFF_XB) + tok * D_ + 512 + hd * 64;
#pragma unroll
  for (int dt = 0; dt < 4; ++dt) { const int dv = dt * 16 + 4 * quad; const uint2 wv = *(const uint2*)(ow + dv);
    const float w0 = __uint_as_float(wv.x << 16), w1 = __uint_as_float(wv.x & 0xffff0000u), w2 = __uint_as_float(wv.y << 16), w3 = __uint_as_float(wv.y & 0xffff0000u);
    uint2 pk; pk.x = pack2(g0 * Oc[dt][0] + g1 * Os[dt][0] * inv2 + g2 * w0, g0 * Oc[dt][1] + g1 * Os[dt][1] * inv2 + g2 * w1);
    pk.y = pack2(g0 * Oc[dt][2] + g1 * Os[dt][2] * inv2 + g2 * w2, g0 * Oc[dt][3] + g1 * Os[dt][3] * inv2 + g2 * w3);
    *(uint2*)(mix + dv) = pk; }
}

DI int q_pop(unsigned* ctr, char* smem) {
  int* sh = (int*)(smem + 65024);
  __syncthreads();
  if (tid_() == 0) *sh = (int)atomicAdd(ctr, 1u);
  __syncthreads();
  return *sh;
}
DI void m1_phase(const Params& p, int l, char* smem, int cslot = 0, int skip = 0) {
  unsigned* ctr = (unsigned*)(p.ws + OFF_CNT) + cslot;
  const int total = 32 + 64 * 24 + 256;
  bool first = true;
  for (;;) {
    const int it = (first ? (int)blockIdx.x : q_pop(ctr, smem) + (int)gridDim.x) + skip; first = false;
    if (it >= total) break;
#ifndef M1SEL
#define M1SEL 31
#endif
    if (it < 32) { if (M1SEL & 1) gdn_chain(p, it, smem); }
    else if (it < 32 + 256) { if (M1SEL & 16) nsa_compress(p, l, it - 32, smem); }
    else { const int j = it - 288, kind = j >> 9, jj = j & 511, qb = 63 - (jj >> 3), bh = jj & 7, b = bh >> 2, hh = bh & 3;
      if (kind == 0) { if (M1SEL & 4) diff_item(p, l, b, hh, qb, smem); } else if (kind == 1) { if (M1SEL & 8) win_item(p, b, hh, qb, smem); } else { if (M1SEL & 2) sb_item(p, b, hh, qb, smem); } }
  }
}
DI void m2_phase(const Params& p, int l, char* smem, int cslot = 16) {
  unsigned* ctr = (unsigned*)(p.ws + OFF_CNT) + cslot;
  const int total = 1024, wave = tid_() >> 6;
  for (int it = blockIdx.x; it < 1024; it += gridDim.x) gdn_g3(p, l, it, smem);
  bool first = true;
  for (;;) {
    const int it = first ? (int)blockIdx.x : q_pop(ctr, smem) + (int)gridDim.x;
    if (first) __syncthreads();
    first = false;
    if (it >= total) break;
    { const int item = 1023 - it;
      nsa_group(p, item * 16 + wave * 4, (float*)smem + wave * 1152); }
  }
}

struct XB { unsigned x, nloc, nx; };
#define XB_XCNT(j) (64 * (j))
#define XB_XSUB(j) (64 * (16 + (j)))
#define XB_XGEN(j) (64 * (32 + (j)))
#define XB_TOP (64 * 48)
#define XB_TOPGEN (64 * 49)
DI unsigned xb_ld(unsigned* p) { return __hip_atomic_load(p, __ATOMIC_RELAXED, __HIP_MEMORY_SCOPE_AGENT); }
DI unsigned xb_add(unsigned* p, unsigned v) { return __hip_atomic_fetch_add(p, v, __ATOMIC_RELAXED, __HIP_MEMORY_SCOPE_AGENT); }
DI unsigned xb_xcc_id() { return (unsigned)__builtin_amdgcn_s_getreg((3 << 11) | 20) & 0xFu; }
#define XB_SPIN(cond) do { unsigned sp_ = 0; while ((cond) && ++sp_ < (1u << 24)) __builtin_amdgcn_s_sleep(1); } while (0)
DI void xcd_barrier(unsigned* bar, const XB& b) {
  asm volatile("s_waitcnt vmcnt(0)" ::: "memory");
  __syncthreads();
  if (tid_() == 0) {
    asm volatile("s_waitcnt vmcnt(0) lgkmcnt(0)" ::: "memory");
    const unsigned old = xb_add(bar + XB_XSUB(b.x), 1u), gen = old / b.nloc;
    if (old + 1u == (gen + 1u) * b.nloc) {
      __builtin_amdgcn_fence(__ATOMIC_RELEASE, "agent");
      asm volatile("s_waitcnt vmcnt(0)" ::: "memory");
      const unsigned og = xb_add(bar + XB_TOP, 1u), tg = og / b.nx;
      if (og + 1u == (tg + 1u) * b.nx) xb_add(bar + XB_TOPGEN, 1u);
      else XB_SPIN(xb_ld(bar + XB_TOPGEN) == tg);
      __builtin_amdgcn_fence(__ATOMIC_ACQUIRE, "agent");
      xb_add(bar + XB_XGEN(b.x), 1u);
      asm volatile("s_waitcnt vmcnt(0)" ::: "memory");
    } else {
      XB_SPIN(xb_ld(bar + XB_XGEN(b.x)) == gen);
      __builtin_amdgcn_fence(__ATOMIC_ACQUIRE, "agent");
      asm volatile("s_waitcnt vmcnt(0)" ::: "memory");
    }
  }
  __syncthreads();
}
constexpr int NPHASE = 25;
DI void run_phase(const Params& p, int ph, char* smem) {
  if (ph == 0) { prologue_phase(p); convert_weights(p, 0, 1, smem); return; }
  const int l = (ph - 1) / 12, sp = (ph - 1) % 12;
  const float alpha = 1.4142135623730951f;
  bf16_t* xb = (bf16_t*)(p.ws + OFF_XB); bf16_t* big = (bf16_t*)(p.ws + OFF_BIG);
  const bf16_t* wgu = (const bf16_t*)(p.ws + OFF_GU); const bf16_t* wdn = (const bf16_t*)(p.ws + OFF_DN);
  EpiArgs e; e.obf = big; e.resid = p.out; e.of32 = p.out; e.alpha = alpha; e.sc = 0.5f; e.rope = (const float*)(p.ws + OFF_ROPE);
  switch (sp) {
    case 0: case 9: gemm_phase<0>(xb, D_, wgu, D_, 2 * DFF, smem, e); break;
    case 1: if (l == 0) e.resid = p.x; gemm_phase<2>(big, DFF, wdn, DFF, D_, smem, e); break;
    case 10: gemm_phase<2>(big, DFF, wdn, DFF, D_, smem, e); break;
    case 2: ln_phase(p.out, xb, p.ln1g + l * D_, p.ln1b + l * D_); break;
    case 3: gemm_phase<1>(xb, D_, (const bf16_t*)(p.ws + OFF_WIN), D_, LDP, smem, e); break;
    case 4: m0_phase(p, l, smem); break;
    case 5: m1_phase(p, l, smem); break;
    case 6: m2_phase(p, l, smem); break;
    case 7: e.sc = 1.f; gemm_phase<2>(xb, D_, (const bf16_t*)(p.ws + OFF_WOUT), D_, D_, smem, e); break;
    case 8: ln_phase(p.out, xb, p.ln2g + l * D_, p.ln2b + l * D_); convert_weights(p, l, 2, smem); break;
    case 11: ln_phase(p.out, xb, p.ln3g + l * D_, p.ln3b + l * D_); if (l + 1 < 2) convert_weights(p, l + 1, 1, smem); break;
  }
}
__global__ void __launch_bounds__(256, 2) mega(Params p, int ph0, int ph1, int coop) {
  __shared__ __attribute__((aligned(16))) char smem[65536];
#ifdef PHASE_ONLY
  run_phase(p, PHASE_ONLY, smem); return;
#endif
  XB xb; xb.x = xb_xcc_id(); xb.nloc = 1u; xb.nx = 1u;
  unsigned* bar = (unsigned*)(p.ws + OFF_BAR);
  if (coop && tid_() == 0) xb_add(bar + XB_XCNT(xb.x), 1u);
  for (int ph = ph0; ph < ph1; ++ph) {
    const Params& q = p;
    run_phase(q, ph, smem);
#ifdef PROBE_DUP
    { const int sp = (ph - 1) % 12; const int l = (ph - 1) / 12;
      if (ph > 0 && PROBE_DUP == 1 && (sp == 0 || sp == 9)) { cg::this_grid().sync(); run_phase(q, ph, smem); }
      if (ph > 0 && PROBE_DUP == 2 && sp == 5) { cg::this_grid().sync(); m1_phase(q, l, smem, 32, 32); }
      if (ph > 0 && PROBE_DUP == 3 && sp == 6) { cg::this_grid().sync(); m2_phase(q, l, smem, 48); }
      if (ph > 0 && PROBE_DUP == 6 && sp == 6) { cg::this_grid().sync(); for (int it = blockIdx.x; it < 1024; it += gridDim.x) gdn_g3(q, l, it, smem); }
      if (ph > 0 && PROBE_DUP == 7 && sp == 4) { cg::this_grid().sync(); for (int it = blockIdx.x; it < 2560; it += gridDim.x) vt_tile(q, it, smem); }
      if (PROBE_DUP == 8 && ph < 20) { cg::this_grid().sync(); cg::this_grid().sync(); }
      if (ph > 0 && PROBE_DUP == 4 && sp == 3) { cg::this_grid().sync(); run_phase(q, ph, smem); }
      if (ph > 0 && PROBE_DUP == 5 && sp == 4) { cg::this_grid().sync(); for (int it = blockIdx.x; it < 2560 + 1024; it += gridDim.x) { if (it < 1024) gdn_g1(q, l, it, smem); else vt_tile(q, it - 1024, smem); } } }
#endif
    if (coop && ph + 1 < ph1) {
      if (ph == 0) { cg::this_grid().sync();
        unsigned mine = 0u, cnt = 0u;
        for (unsigned j = 0; j < 16; ++j) { const unsigned c = xb_ld(bar + XB_XCNT(j)); cnt += c > 0u ? 1u : 0u; mine = (j == xb.x) ? c : mine; }
        xb.nloc = mine > 0u ? mine : 1u; xb.nx = cnt > 0u ? cnt : 1u; }
      else xcd_barrier(bar, xb);
    }
  }
}

extern "C" void kernel_launch(void* const* d_in, const int* in_sizes, int n_in, void* d_out, int out_size, void* d_ws, size_t ws_size, hipStream_t stream) {
  Params p{};
  const float** f = (const float**)&p;
  for (int i = 0; i < 28; ++i) f[i] = (const float*)d_in[i];
  p.out = (float*)d_out; p.ws = (char*)d_ws;
  static int grid_blocks = 0;
  if (!grid_blocks) {
    int dev = 0, cus = 0, per_cu = 0;
    hipGetDevice(&dev);
    hipDeviceGetAttribute(&cus, hipDeviceAttributeMultiprocessorCount, dev);
    hipOccupancyMaxActiveBlocksPerMultiprocessor(&per_cu, mega, 256, 0);
    if (per_cu < 1) per_cu = 1;
    if (per_cu > 2) per_cu = 2;
    grid_blocks = cus * per_cu;
  }
  if (ws_size < WS_NEED) { fprintf(stderr, "workspace too small: %zu < %zu\n", ws_size, (size_t)WS_NEED); return; }
#if MK_COOP
  hipMemsetAsync((char*)d_ws + OFF_BAR, 0, 32768, stream);
  int ph0 = 0, ph1 = NPHASE, coop = 1;
  void* args[] = {&p, &ph0, &ph1, &coop};
  hipError_t e = hipLaunchCooperativeKernel((void*)mega, dim3(grid_blocks), dim3(256), args, 0, stream);
  if (e != hipSuccess) fprintf(stderr, "cooperative launch failed: %s (grid %d)\n", hipGetErrorString(e), grid_blocks);
#else
  for (int ph = 0; ph < NPHASE; ++ph) hipLaunchKernelGGL(mega, dim3(grid_blocks), dim3(256), 0, stream, p, ph, ph + 1, 0);
#endif
}
```

```cpp
#include <hip/hip_runtime.h>
#include <hip/hip_cooperative_groups.h>
#include <stdint.h>
#include <cstdio>
namespace cg = cooperative_groups;

#ifndef MK_COOP
#define MK_COOP 1
#endif

#define DI __device__ __forceinline__
typedef unsigned short bf16_t;
typedef short bf16x8 __attribute__((ext_vector_type(8)));
typedef short s16x4 __attribute__((ext_vector_type(4)));
typedef float f32x4 __attribute__((ext_vector_type(4)));
typedef float f32x16 __attribute__((ext_vector_type(16)));
typedef unsigned u32x4 __attribute__((ext_vector_type(4)));

constexpr int T_ = 16384, S_ = 8192, D_ = 1024, DFF = 2816, LDP = 3328;
constexpr int VLD = T_ + 128;
constexpr int CLD = 544;
constexpr int C_DQ1 = 0, C_DQ2 = 128, C_DK1 = 256, C_DK2 = 384, C_DV = 512, C_GQ = 768, C_GK = 1024, C_GV = 1280, C_GZ = 1536,
              C_NQ = 1792, C_NKC = 2048, C_NVC = 2112, C_NKS = 2176, C_NVS = 2240, C_NKW = 2304, C_NVW = 2368,
              C_SQ = 2432, C_SK = 2688, C_SV = 2944, C_GA = 3200, C_GB = 3204, C_NG = 3208;

constexpr size_t OFF_GU = 0, OFF_DN = 11534336, OFF_WIN = OFF_DN + 5767168, OFF_WOUT = OFF_WIN + 6815744;
constexpr size_t OFF_VT = 0;
constexpr size_t OFF_XB = OFF_WOUT + 2097152;
constexpr size_t OFF_BIG = OFF_XB + 33554432;
constexpr size_t OFF_GU_ = OFF_BIG + 109051904;
constexpr size_t OFF_GW = OFF_GU_ + 16777216, OFF_GKD = OFF_GW + 16777216, OFF_GS = OFF_GKD + 16777216;
constexpr size_t OFF_OWIN = OFF_GS + 16777216;
constexpr size_t OFF_ROPE = OFF_OWIN + 8388608;
constexpr size_t OFF_KCMP = OFF_ROPE + 3145728, OFF_VCMP = OFF_KCMP + 262144;
constexpr size_t OFF_GLAST = OFF_VCMP + 262144;
constexpr size_t OFF_CNT = OFF_GLAST + 4096;
constexpr size_t OFF_BAR = OFF_CNT + 512;
constexpr size_t WS_NEED = OFF_BAR + 32768;

struct Params {
  const float *x, *w_in, *w_out, *gu1, *dn1, *gu2, *dn2;
  const float *ln1g, *ln1b, *ln2g, *ln2b, *ln3g, *ln3b;
  const float *lq1, *lk1, *lq2, *lk2, *subln;
  const float *convw, *alog, *dtb, *gdng;
  const float *pek, *pev, *ckw1, *ckw2, *cvw1, *cvw2;
  float* out; char* ws;
};

DI int tid_() { int t = __builtin_amdgcn_workitem_id_x(); asm volatile("" : "+v"(t)); return t; }
DI float bf2f(bf16_t v) { return __uint_as_float(((unsigned)v) << 16); }
DI bf16_t f2bf(float f) { unsigned u = __float_as_uint(f); u += 0x7fffu + ((u >> 16) & 1u); return (bf16_t)(u >> 16); }
DI unsigned pack2(float a, float b) { return (unsigned)f2bf(a) | ((unsigned)f2bf(b) << 16); }
DI float fexp2(float x) { return __builtin_amdgcn_exp2f(x); }
DI float fexp(float x) { return __builtin_amdgcn_exp2f(x * 1.4426950408889634f); }
DI float flog(float x) { return __builtin_amdgcn_logf(x) * 0.6931471805599453f; }
DI float wave_max(float v) { for (int o = 32; o >= 1; o >>= 1) v = fmaxf(v, __shfl_xor(v, o)); return v; }
DI float wave_sum(float v) { for (int o = 32; o >= 1; o >>= 1) v += __shfl_xor(v, o); return v; }
#define WAVE_SYNC() do { __builtin_amdgcn_fence(__ATOMIC_RELEASE, "wavefront"); __builtin_amdgcn_wave_barrier(); __builtin_amdgcn_fence(__ATOMIC_ACQUIRE, "wavefront"); } while (0)
DI uint4 gld16(const void* p) { uint4 r; asm volatile("global_load_dwordx4 %0, %1, off" : "=v"(r) : "v"(p) : "memory"); return r; }
DI float4 gldf4(const void* p) { float4 r; asm volatile("global_load_dwordx4 %0, %1, off" : "=v"(r) : "v"(p) : "memory"); return r; }
DI u32x4 gldv(const void* p) { u32x4 r; asm volatile("global_load_dwordx4 %0, %1, off" : "=v"(r) : "v"(p) : "memory"); return r; }
DI f32x4 gldfv(const void* p) { f32x4 r; asm volatile("global_load_dwordx4 %0, %1, off" : "=v"(r) : "v"(p) : "memory"); return r; }
DI float gld32(const void* p) { float r; asm volatile("global_load_dword %0, %1, off" : "=v"(r) : "v"(p) : "memory"); return r; }
DI void vm_wait0() { asm volatile("s_waitcnt vmcnt(0)" ::: "memory"); }
DI int crow(int i, int h) { return (i & 3) + 8 * (i >> 2) + 4 * h; }
#define MFMA16(a, b, c) __builtin_amdgcn_mfma_f32_16x16x32_bf16((a), (b), (c), 0, 0, 0)
#define MFMA32(a, b, c) __builtin_amdgcn_mfma_f32_32x32x16_bf16((a), (b), (c), 0, 0, 0)

DI int src_col(int n, int mode) {
  if (mode == 1) { int t16 = n >> 4; return (t16 & 1) * DFF + (t16 >> 1) * 16 + (n & 15); }
  if (mode == 2) {
    if (n < 1792) return n;
    if (n < 2432) return n + 8;
    if (n < 3200) return n + 20;
    if (n < 3208) return 1792 + (n - 3200);
    if (n < 3220) return 2440 + (n - 3208);
    return -1;
  }
  return n;
}
DI void conv_tile(const float* __restrict__ W, int K, int N, bf16_t* __restrict__ Wt, int mode, int tile, char* smem) {
  float* tl = (float*)smem;
  const int nK = K >> 6, kt = tile % nK, nt = tile / nK, k0 = kt * 64, n0 = nt * 64, tid = tid_();
  __syncthreads();
  { const int c = tid & 63, sc = src_col(n0 + c, mode); const int scc = sc >= 0 ? sc : 0; float wv[16];
#pragma unroll
    for (int i = 0; i < 16; ++i) wv[i] = gld32(W + (size_t)(k0 + (tid >> 6) + 4 * i) * N + scc);
    asm volatile("s_waitcnt vmcnt(0)" : "+v"(wv[0]), "+v"(wv[1]), "+v"(wv[2]), "+v"(wv[3]), "+v"(wv[4]), "+v"(wv[5]), "+v"(wv[6]), "+v"(wv[7]), "+v"(wv[8]), "+v"(wv[9]), "+v"(wv[10]), "+v"(wv[11]), "+v"(wv[12]), "+v"(wv[13]), "+v"(wv[14]), "+v"(wv[15]) :: "memory");
#pragma unroll
    for (int i = 0; i < 16; ++i) { const int r = (tid >> 6) + 4 * i; tl[r * 65 + c] = (sc >= 0) ? wv[i] : 0.f; } }
  __syncthreads();
  { const int kk2 = (tid & 31) * 2;
#pragma unroll
    for (int i = 0; i < 8; ++i) { const int nn = (tid >> 5) + 8 * i; *(unsigned*)(Wt + (size_t)(n0 + nn) * K + k0 + kk2) = pack2(tl[kk2 * 65 + nn], tl[(kk2 + 1) * 65 + nn]); } }
}
DI void convert_weights(const Params& p, int l, int which  , char* smem) {
  bf16_t* gu = (bf16_t*)(p.ws + OFF_GU); bf16_t* dn = (bf16_t*)(p.ws + OFF_DN);
  const float* sgu = (which == 1 ? p.gu1 : p.gu2) + (size_t)l * D_ * 2 * DFF;
  const float* sdn = (which == 1 ? p.dn1 : p.dn2) + (size_t)l * DFF * D_;
  const int n_gu = 16 * 88, n_dn = 44 * 16, n_in = (which == 1) ? 16 * 52 : 0, n_out = (which == 1) ? 256 : 0;
  const int total = n_gu + n_dn + n_in + n_out;
  for (int it = blockIdx.x; it < total; it += gridDim.x) {
    if (it < n_gu) conv_tile(sgu, D_, 2 * DFF, gu, 1, it, smem);
    else if (it < n_gu + n_dn) conv_tile(sdn, DFF, D_, dn, 0, it - n_gu, smem);
    else if (it < n_gu + n_dn + n_in) conv_tile(p.w_in + (size_t)l * D_ * 3220, D_, 3220, (bf16_t*)(p.ws + OFF_WIN), 2, it - n_gu - n_dn, smem);
    else conv_tile(p.w_out + (size_t)l * D_ * D_, D_, D_, (bf16_t*)(p.ws + OFF_WOUT), 0, it - n_gu - n_dn - n_in, smem);
  }
}

struct EpiArgs { bf16_t* obf; const float* resid; float* of32; float alpha, sc; const float* rope; };
DI void vm_wait8() { asm volatile("s_waitcnt vmcnt(8)" ::: "memory"); }
template <int EPI>
DI void gemm_epilogue(f32x4 (&acc)[4][4], int m0, int n0, int wm, int wn, int l15, int quad, const EpiArgs& e) {
#pragma unroll
  for (int mt = 0; mt < 4; ++mt) {
    const size_t row = (size_t)(m0 + wm * 64 + mt * 16 + l15);
    if (EPI == 0) {
#pragma unroll
      for (int q = 0; q < 2; ++q) {
        const int j = ((n0 >> 5) + wn * 2 + q) * 16 + 4 * quad; float hv[4];
#pragma unroll
        for (int i = 0; i < 4; ++i) { const float g = acc[mt][2 * q][i], u = acc[mt][2 * q + 1][i]; hv[i] = g * __builtin_amdgcn_rcpf(1.f + fexp(-g)) * u; }
        *(uint2*)(e.obf + row * DFF + j) = (uint2){pack2(hv[0], hv[1]), pack2(hv[2], hv[3])};
      }
    } else if (EPI == 1) {
      const int cb = n0 + wn * 64, spos = (int)(row & (size_t)(S_ - 1));
      const bool rd = cb < 512, rn = (cb >= C_NQ && cb < C_NKC + 64) || cb == C_NKS || cb == C_NKW;
      if (rd) {
        const f32x4 cs = *(const f32x4*)(e.rope + spos * 16 + 4 * quad), sn = *(const f32x4*)(e.rope + S_ * 16 + spos * 16 + 4 * quad);
#pragma unroll
        for (int g = 0; g < 2; ++g) { const f32x4 t1 = acc[mt][2 * g], t2 = acc[mt][2 * g + 1]; acc[mt][2 * g] = t1 * cs - t2 * sn; acc[mt][2 * g + 1] = t2 * cs + t1 * sn; }
      } else if (rn) {
#pragma unroll
        for (int g = 0; g < 2; ++g) {
          const f32x4 cs = *(const f32x4*)(e.rope + S_ * 32 + spos * 32 + g * 16 + 4 * quad), sn = *(const f32x4*)(e.rope + S_ * 64 + spos * 32 + g * 16 + 4 * quad);
          const f32x4 t1 = acc[mt][g], t2 = acc[mt][g + 2]; acc[mt][g] = t1 * cs - t2 * sn; acc[mt][g + 2] = t2 * cs + t1 * sn; }
      }
#pragma unroll
      for (int nt = 0; nt < 4; ++nt) { const int col = n0 + wn * 64 + nt * 16 + 4 * quad;
        *(uint2*)(e.obf + row * LDP + col) = (uint2){pack2(acc[mt][nt][0], acc[mt][nt][1]), pack2(acc[mt][nt][2], acc[mt][nt][3])}; }
    } else {
      float4 rv[4];
#pragma unroll
      for (int nt = 0; nt < 4; ++nt) rv[nt] = *(const float4*)(e.resid + row * D_ + n0 + wn * 64 + nt * 16 + 4 * quad);
#pragma unroll
      for (int nt = 0; nt < 4; ++nt) { const f32x4 a = acc[mt][nt];
        *(float4*)(e.of32 + row * D_ + n0 + wn * 64 + nt * 16 + 4 * quad) = (float4){e.alpha * rv[nt].x + e.sc * a[0], e.alpha * rv[nt].y + e.sc * a[1], e.alpha * rv[nt].z + e.sc * a[2], e.alpha * rv[nt].w + e.sc * a[3]}; }
    }
  }
#pragma unroll
  for (int i = 0; i < 4; ++i)
#pragma unroll
    for (int j = 0; j < 4; ++j) acc[i][j] = (f32x4){0.f, 0.f, 0.f, 0.f};
}
DI void gemm_compute(const bf16_t* sb, int wm, int wn, int l15, int quad, f32x4 (&acc)[4][4]) {
#pragma unroll
  for (int ks = 0; ks < 2; ++ks) {
    bf16x8 af[4], bfr[4];
#pragma unroll
    for (int mt = 0; mt < 4; ++mt) af[mt] = *(const bf16x8*)(sb + ((ks * 4 + quad) * 128 + wm * 64 + mt * 16 + (l15 & 8) + ((l15 + ks * 4 + quad) & 7)) * 8);
#pragma unroll
    for (int nt = 0; nt < 4; ++nt) bfr[nt] = *(const bf16x8*)(sb + 8192 + ((ks * 4 + quad) * 128 + wn * 64 + nt * 16 + (l15 & 8) + ((l15 + ks * 4 + quad) & 7)) * 8);
#pragma unroll
    for (int mt = 0; mt < 4; ++mt)
#pragma unroll
      for (int nt = 0; nt < 4; ++nt) acc[mt][nt] = MFMA16(af[mt], bfr[nt], acc[mt][nt]);
  }
}
DI void gemm_compute_sw(const bf16_t* sb, int wm, int wn, int l15, int quad, f32x4 (&acc)[4][4]) {
#pragma unroll
  for (int ks = 0; ks < 2; ++ks) {
    bf16x8 af[4], bfr[4];
    const int sl = ((ks * 4 + quad) ^ ((l15 >> 1) & 7)) * 8;
#pragma unroll
    for (int mt = 0; mt < 4; ++mt) af[mt] = *(const bf16x8*)(sb + (wm * 64 + mt * 16 + l15) * 64 + sl);
#pragma unroll
    for (int nt = 0; nt < 4; ++nt) bfr[nt] = *(const bf16x8*)(sb + 8192 + (wn * 64 + nt * 16 + l15) * 64 + sl);
#pragma unroll
    for (int mt = 0; mt < 4; ++mt)
#pragma unroll
      for (int nt = 0; nt < 4; ++nt) acc[mt][nt] = MFMA16(bfr[nt], af[mt], acc[mt][nt]);
  }
}
template <int EPI>
DI void gemm_phase(const bf16_t* __restrict__ A, int lda, const bf16_t* __restrict__ Bt, int K, int N, char* smem, const EpiArgs& e) {
  const int NT = N >> 7, ntiles = 128 * NT, nk = K >> 6;
  if ((int)blockIdx.x >= ntiles) return;
  const int cnt = (ntiles - (int)blockIdx.x + (int)gridDim.x - 1) / (int)gridDim.x, total = cnt * nk;
  const int tid = tid_(), lane = tid & 63, wave = __builtin_amdgcn_readfirstlane(tid >> 6), wm = wave >> 1, wn = wave & 1, l15 = lane & 15, quad = lane >> 4;
  bf16_t* sm = (bf16_t*)smem;
  const int lr = wave * 8 + (lane >> 3), lch = (lane & 7) ^ ((lr >> 1) & 7);
#define TILE_MN(tile_, m0_, n0_) { const int x_ = (tile_) & 7, u_ = (tile_) >> 3; m0_ = (x_ * 16 + (u_ & 15)) * 128; n0_ = (u_ >> 4) * 128; }
  int ltile = blockIdx.x, lk = 0, lg = 0; const bf16_t *Ag, *Bg;
  { int m0, n0; TILE_MN(ltile, m0, n0); Ag = A + (size_t)(m0 + lr) * lda + lch * 8; Bg = Bt + (size_t)(n0 + lr) * K + lch * 8; }
#define G_ISSUE(buf_) { bf16_t* sw = sm + (buf_) * 16384 + wave * 512; \
    _Pragma("unroll") for (int q = 0; q < 4; ++q) { \
      __builtin_amdgcn_global_load_lds((const unsigned*)(Ag + (size_t)(32 * q) * lda + lk * 64), (unsigned*)(sw + q * 2048), 16, 0, 0); \
      __builtin_amdgcn_global_load_lds((const unsigned*)(Bg + (size_t)(32 * q) * K + lk * 64), (unsigned*)(sw + 8192 + q * 2048), 16, 0, 0); } \
    if (lg + 1 < total) { ++lg; if (++lk == nk) { lk = 0; ltile += gridDim.x; int m0, n0; TILE_MN(ltile, m0, n0); Ag = A + (size_t)(m0 + lr) * lda + lch * 8; Bg = Bt + (size_t)(n0 + lr) * K + lch * 8; } } }
  f32x4 acc[4][4];
#pragma unroll
  for (int i = 0; i < 4; ++i)
#pragma unroll
    for (int j = 0; j < 4; ++j) acc[i][j] = (f32x4){0.f, 0.f, 0.f, 0.f};
  __syncthreads();
  G_ISSUE(0);
  vm_wait0();
  __syncthreads();
  int ctile = blockIdx.x, ck = 0;
  for (int g = 0; g < total; g += 2) {
    G_ISSUE(1);
    gemm_compute_sw(sm, wm, wn, l15, quad, acc);
    vm_wait0();
    __syncthreads();
    G_ISSUE(0);
    gemm_compute_sw(sm + 16384, wm, wn, l15, quad, acc);
    vm_wait0();
    __syncthreads();
    ck += 2;
    if (ck == nk) { int m0, n0; TILE_MN(ctile, m0, n0); gemm_epilogue<EPI>(acc, m0, n0, wm, wn, l15, quad, e); ck = 0; ctile += gridDim.x; }
  }
#undef G_ISSUE
#undef TILE_MN
}

DI void ln_phase(float* x32, bf16_t* xb, const float* g, const float* b) {
  const int lane = tid_() & 63, wv = tid_() >> 6;
  float4 gg[4], bb[4];
#pragma unroll
  for (int j = 0; j < 4; ++j) { gg[j] = *(const float4*)(g + j * 256 + lane * 4); bb[j] = *(const float4*)(b + j * 256 + lane * 4); }
  for (int row = blockIdx.x * 4 + wv; row < T_; row += gridDim.x * 4) {
    f32x4 v[4];
#pragma unroll
    for (int j = 0; j < 4; ++j) v[j] = gldfv(x32 + (size_t)row * D_ + j * 256 + lane * 4);
    asm volatile("s_waitcnt vmcnt(0)" : "+v"(v[0]), "+v"(v[1]), "+v"(v[2]), "+v"(v[3]) :: "memory");
    float s = 0.f;
#pragma unroll
    for (int j = 0; j < 4; ++j) s += (v[j][0] + v[j][1]) + (v[j][2] + v[j][3]);
    s = wave_sum(s); const float mu = s * (1.f / D_); float q = 0.f;
#pragma unroll
    for (int j = 0; j < 4; ++j) { v[j] -= mu; q += v[j][0] * v[j][0] + v[j][1] * v[j][1] + v[j][2] * v[j][2] + v[j][3] * v[j][3]; }
    q = wave_sum(q); const float rs = rsqrtf(q * (1.f / D_) + 1e-5f);
#pragma unroll
    for (int j = 0; j < 4; ++j) {
      const int c = j * 256 + lane * 4;
      float4 y; y.x = v[j][0] * rs * gg[j].x + bb[j].x; y.y = v[j][1] * rs * gg[j].y + bb[j].y; y.z = v[j][2] * rs * gg[j].z + bb[j].z; y.w = v[j][3] * rs * gg[j].w + bb[j].w;
      *(float4*)(x32 + (size_t)row * D_ + c) = y;
      uint2 pk; pk.x = pack2(y.x, y.y); pk.y = pack2(y.z, y.w); *(uint2*)(xb + (size_t)row * D_ + c) = pk;
    }
  }
}

DI void sincos_d(double r, double& sn, double& cs) {
  const double r2 = r * r; double a = 1.0, c = 1.0;
#pragma unroll
  for (int k = 14; k >= 1; --k) { a = 1.0 - r2 / (double)((2 * k) * (2 * k + 1)) * a; c = 1.0 - r2 / (double)((2 * k - 1) * (2 * k)) * c; }
  sn = r * a; cs = c;
}
DI void prologue_phase(const Params& p) {
  const size_t gt = (size_t)blockIdx.x * 256 + tid_(), gs = (size_t)gridDim.x * 256;
  float* rope = (float*)(p.ws + OFF_ROPE);
  for (size_t idx = gt; idx < (size_t)S_ * 48; idx += gs) {
    const int s = (int)(idx / 48), i = (int)(idx % 48); const int dim = i < 16 ? 32 : 64, fi = i < 16 ? i : i - 16;
    const float inv = powf(10000.f, -((float)(2 * fi) / (float)dim));
    const float ang = (float)s * inv;
    const double a = (double)ang, n = rint(a * 0.15915494309189535), r = a - n * 6.283185307179586;
    double sn, cs; sincos_d(r, sn, cs);
    if (i < 16) { rope[s * 16 + fi] = (float)cs; rope[S_ * 16 + s * 16 + fi] = (float)sn; }
    else { rope[S_ * 32 + s * 32 + fi] = (float)cs; rope[S_ * 64 + s * 32 + fi] = (float)sn; }
  }
  bf16_t* xb = (bf16_t*)(p.ws + OFF_XB);
  for (size_t i4 = gt; i4 < (size_t)T_ * D_ / 4; i4 += gs) {
    const float4 v = ((const float4*)p.x)[i4]; uint2 pk; pk.x = pack2(v.x, v.y); pk.y = pack2(v.z, v.w); ((uint2*)xb)[i4] = pk;
  }
}

DI void rope_phase(const Params& p) {
  bf16_t* proj = (bf16_t*)(p.ws + OFF_BIG); const float* rope = (const float*)(p.ws + OFF_ROPE);
  const size_t gt = (size_t)blockIdx.x * 256 + tid_(), gs = (size_t)gridDim.x * 256;
  for (size_t idx = gt; idx < (size_t)T_ * 60; idx += gs) {
    const int tok = (int)(idx / 60), u = (int)(idx % 60), s = tok & (S_ - 1);
    int c1, half; const float *cp, *sp;
    if (u < 32) { const int g = u >> 1, i0 = (u & 1) * 8; c1 = g * 32 + i0; half = 16; cp = rope + s * 16 + i0; sp = rope + S_ * 16 + s * 16 + i0; }
    else { const int q = u - 32, g = q >> 2, i0 = (q & 3) * 8;
      const int base = g < 4 ? C_NQ + g * 64 : (g == 4 ? C_NKC : (g == 5 ? C_NKS : C_NKW));
      c1 = base + i0; half = 32; cp = rope + S_ * 32 + s * 32 + i0; sp = rope + S_ * 64 + s * 32 + i0; }
    bf16_t* row = proj + (size_t)tok * LDP + c1;
    u32x4 a = gldv(row), bq = gldv(row + half); f32x4 c0 = gldfv(cp), c4 = gldfv(cp + 4), s0 = gldfv(sp), s4 = gldfv(sp + 4);
    asm volatile("s_waitcnt vmcnt(0)" : "+v"(a), "+v"(bq), "+v"(c0), "+v"(c4), "+v"(s0), "+v"(s4) :: "memory");
    u32x4 oa, ob;
#pragma unroll
    for (int w = 0; w < 4; ++w) {
      const float t1a = __uint_as_float(a[w] << 16), t1b = __uint_as_float(a[w] & 0xffff0000u), t2a = __uint_as_float(bq[w] << 16), t2b = __uint_as_float(bq[w] & 0xffff0000u);
      const float ca = w < 2 ? c0[2 * w] : c4[2 * w - 4], cb = w < 2 ? c0[2 * w + 1] : c4[2 * w - 3], sa = w < 2 ? s0[2 * w] : s4[2 * w - 4], sb = w < 2 ? s0[2 * w + 1] : s4[2 * w - 3];
      oa[w] = pack2(t1a * ca - t2a * sa, t1b * cb - t2b * sb); ob[w] = pack2(t2a * ca + t1a * sa, t2b * cb + t1b * sb);
    }
    *(u32x4*)row = oa; *(u32x4*)(row + half) = ob;
  }
}
DI void vt_tile(const Params& p, int item, char* smem) {
  const bf16_t* proj = (const bf16_t*)(p.ws + OFF_BIG); bf16_t* vt = (bf16_t*)(p.ws + OFF_VT);
  const int slot = item >> 8, t0 = (item & 255) * 64, tid = tid_();
  const int col = slot < 4 ? C_DV + slot * 64 : (slot < 8 ? C_SV + (slot - 4) * 64 : (slot == 8 ? C_NVW : C_NVS));
  bf16_t* tl = (bf16_t*)smem;
  __syncthreads();
#pragma unroll
  for (int i = 0; i < 2; ++i) { const int idx = tid + 256 * i, tk = idx >> 3, c = idx & 7;
    const uint4 v = *(const uint4*)(proj + (size_t)(t0 + tk) * LDP + col + c * 8);
    unsigned* d = (unsigned*)(tl + tk * 66 + c * 8); d[0] = v.x; d[1] = v.y; d[2] = v.z; d[3] = v.w; }
  __syncthreads();
#pragma unroll
  for (int i = 0; i < 8; ++i) { const int idx = tid + 256 * i, dv = idx >> 5, t2 = (idx & 31) * 2;
    const unsigned v = (unsigned)tl[t2 * 66 + dv] | ((unsigned)tl[(t2 + 1) * 66 + dv] << 16);
    *(unsigned*)(vt + (size_t)(slot * 64 + dv) * VLD + t0 + t2) = v; }
}
DI void gdn_conv(const Params& p, int l, int b, int hh, int s0, int which, float* dst, int ld, bool norm, float scale) {
  const bf16_t* proj = (const bf16_t*)(p.ws + OFF_BIG);
  const int tid = tid_(), c = tid >> 2, part = tid & 3;
  const int colbase = (which == 0 ? C_GQ : (which == 1 ? C_GK : C_GV)) + hh * 64 + part * 16, wch = which * 256 + hh * 64 + part * 16;
  u32x4 xv[8]; f32x4 wv[16];
#pragma unroll
  for (int j = 0; j < 4; ++j) {
    int sj = s0 + c - 3 + j; if (sj < 0) sj = 0;
    const bf16_t* xr = proj + (size_t)(b * S_ + sj) * LDP + colbase;
    xv[2 * j] = gldv(xr); xv[2 * j + 1] = gldv(xr + 8);
    const float* wr = p.convw + (size_t)(l * 4 + j) * 768 + wch;
#pragma unroll
    for (int q = 0; q < 4; ++q) wv[4 * j + q] = gldfv(wr + 4 * q);
  }
  asm volatile("s_waitcnt vmcnt(0)" : "+v"(xv[0]), "+v"(xv[1]), "+v"(xv[2]), "+v"(xv[3]), "+v"(xv[4]), "+v"(xv[5]), "+v"(xv[6]), "+v"(xv[7]),
               "+v"(wv[0]), "+v"(wv[1]), "+v"(wv[2]), "+v"(wv[3]), "+v"(wv[4]), "+v"(wv[5]), "+v"(wv[6]), "+v"(wv[7]),
               "+v"(wv[8]), "+v"(wv[9]), "+v"(wv[10]), "+v"(wv[11]), "+v"(wv[12]), "+v"(wv[13]), "+v"(wv[14]), "+v"(wv[15]) :: "memory");
  float acc[16];
#pragma unroll
  for (int d = 0; d < 16; ++d) acc[d] = 0.f;
#pragma unroll
  for (int j = 0; j < 4; ++j) {
    const float msk = (s0 + c - 3 + j >= 0) ? 1.f : 0.f;
#pragma unroll
    for (int q = 0; q < 4; ++q) {
      const unsigned x0 = xv[2 * j + (q >> 1)][(q & 1) * 2], x1 = xv[2 * j + (q >> 1)][(q & 1) * 2 + 1]; const f32x4 w = wv[4 * j + q];
      acc[4 * q] += msk * w[0] * __uint_as_float(x0 << 16); acc[4 * q + 1] += msk * w[1] * __uint_as_float(x0 & 0xffff0000u);
      acc[4 * q + 2] += msk * w[2] * __uint_as_float(x1 << 16); acc[4 * q + 3] += msk * w[3] * __uint_as_float(x1 & 0xffff0000u);
    }
  }
  float ss = 0.f;
#pragma unroll
  for (int d = 0; d < 16; ++d) { acc[d] = acc[d] / (1.f + __expf(-acc[d])); ss += acc[d] * acc[d]; }
  if (norm) { ss += __shfl_xor(ss, 1); ss += __shfl_xor(ss, 2); const float rn = rsqrtf(ss + 1e-6f) * scale;
#pragma unroll
    for (int d = 0; d < 16; ++d) acc[d] *= rn; }
#pragma unroll
  for (int d = 0; d < 16; ++d) dst[c * ld + part * 16 + d] = acc[d];
}
DI float softplus_f(float x) { return x > 20.f ? x : log1pf(expf(x)); }
DI void gdn_gates(const Params& p, int l, int b, int hh, int s0, float* sG, float* sBeta) {
  const bf16_t* proj = (const bf16_t*)(p.ws + OFF_BIG); const int tid = tid_();
  if (tid < 64) { const bf16_t* row = proj + (size_t)(b * S_ + s0 + tid) * LDP;
    const float a = bf2f(row[C_GA + hh]), bb = bf2f(row[C_GB + hh]);
    sG[tid] = -expf(p.alog[l * 4 + hh]) * softplus_f(a + p.dtb[l * 4 + hh]); sBeta[tid] = 1.f / (1.f + expf(-bb)); }
  __syncthreads();
  if (tid < 64) { float v = sG[tid];
#pragma unroll
    for (int o = 1; o < 64; o <<= 1) { const float u = __shfl_up(v, o); if (tid >= o) v += u; }
    sG[tid] = v; }
  __syncthreads();
}
DI void gdn_g1(const Params& p, int l, int ch, char* smem) {
  const int b = ch >> 9, hh = (ch >> 7) & 3, n = ch & 127, s0 = n * 64, tid = tid_(), c = tid >> 2, part = tid & 3;
  float* sA = (float*)smem; float* sR = sA + 4096; float* sG = sR + 64 * 129; float* sBeta = sG + 64;
  float* U = (float*)(p.ws + OFF_GU_) + (size_t)ch * 4096; float* W = (float*)(p.ws + OFF_GW) + (size_t)ch * 4096; float* KD = (float*)(p.ws + OFF_GKD) + (size_t)ch * 4096;
  __syncthreads();
  gdn_gates(p, l, b, hh, s0, sG, sBeta);
  gdn_conv(p, l, b, hh, s0, 1, sR + 64, 129, true, 1.f);
  gdn_conv(p, l, b, hh, s0, 2, sR, 129, false, 1.f);
  __syncthreads();
  const float Glast = sG[63], Gc = sG[c], bc = sBeta[c];
  { const float f = expf(Glast - Gc);
#pragma unroll
    for (int d = 0; d < 16; ++d) KD[c * 64 + part * 16 + d] = sR[c * 129 + 64 + part * 16 + d] * f; }
  for (int i = 0; i < 16; ++i) { const int s = part + 4 * i; float a = 0.f;
    if (s < c) { float dot = 0.f;
#pragma unroll 16
      for (int d = 0; d < 64; ++d) dot += sR[c * 129 + 64 + d] * sR[s * 129 + 64 + d];
      a = bc * dot * expf(Gc - sG[s]); }
    sA[c * 64 + s] = a; }
  __syncthreads();
  { const float f2 = bc * expf(Gc);
#pragma unroll
    for (int d = 0; d < 16; ++d) { sR[c * 129 + part * 16 + d] *= bc; sR[c * 129 + 64 + part * 16 + d] *= f2; } }
  __syncthreads();
  if (tid < 128) {
    float sol[64];
#pragma unroll
    for (int cc = 0; cc < 64; ++cc) sol[cc] = sR[cc * 129 + tid];
#pragma unroll
    for (int cc = 1; cc < 64; ++cc) { float a0 = 0.f, a1 = 0.f;
#pragma unroll
      for (int s2 = 0; s2 < cc; ++s2) { if (s2 & 1) a1 += sA[cc * 64 + s2] * sol[s2]; else a0 += sA[cc * 64 + s2] * sol[s2]; }
      sol[cc] -= a0 + a1; }
#pragma unroll
    for (int cc = 1; cc < 64; ++cc) sR[cc * 129 + tid] = sol[cc];
  }
  __syncthreads();
#pragma unroll
  for (int d = 0; d < 16; ++d) { U[c * 64 + part * 16 + d] = sR[c * 129 + part * 16 + d]; W[c * 64 + part * 16 + d] = sR[c * 129 + 64 + part * 16 + d]; }
  if (tid == 0) ((float*)(p.ws + OFF_GLAST))[ch] = expf(Glast);
}
DI void m0_phase(const Params& p, int l, char* smem) {
  if (blockIdx.x == 0 && tid_() < 64) ((unsigned*)(p.ws + OFF_CNT))[tid_()] = 0u;
  for (int it = blockIdx.x; it < 2560 + 1024; it += gridDim.x) {
    if (it < 1024) gdn_g1(p, l, it, smem); else vt_tile(p, it - 1024, smem);
  }
}

struct KVRegs { u32x4 k[2], v[2]; };
DI void kv_wait(KVRegs& rg) { asm volatile("s_waitcnt vmcnt(0)" : "+v"(rg.k[0]), "+v"(rg.k[1]), "+v"(rg.v[0]), "+v"(rg.v[1]) :: "memory"); }
template <int DQK> DI void kv_issue(const bf16_t* Kb, const bf16_t* Vt, int k0, KVRegs& rg) {
  const int tid = tid_();
  if (DQK == 64) {
#pragma unroll
    for (int q = 0; q < 2; ++q) { const int idx = tid + 256 * q, key = idx >> 3, c = idx & 7; rg.k[q] = gldv(Kb + (size_t)(k0 + key) * LDP + c * 8); }
  } else { const int key = tid >> 2, c = tid & 3; rg.k[0] = gldv(Kb + (size_t)(k0 + key) * LDP + c * 8); }
#pragma unroll
  for (int q = 0; q < 2; ++q) { const int idx = tid + 256 * q, dv = idx >> 3, c = idx & 7; rg.v[q] = gldv(Vt + (size_t)dv * VLD + k0 + c * 8); }
}
template <int DQK> DI void kv_commit(const KVRegs& rg, bf16_t* sK, bf16_t* sV) {
  constexpr int LDK = DQK + 8; const int tid = tid_();
  if (DQK == 64) {
#pragma unroll
    for (int q = 0; q < 2; ++q) { const int idx = tid + 256 * q, key = idx >> 3, c = idx & 7; *(u32x4*)(sK + key * LDK + c * 8) = rg.k[q]; }
  } else { const int key = tid >> 2, c = tid & 3; *(u32x4*)(sK + key * LDK + c * 8) = rg.k[0]; }
#pragma unroll
  for (int q = 0; q < 2; ++q) { const int idx = tid + 256 * q, dv = idx >> 3, c = idx & 7; const u32x4 v = rg.v[q];
    uint2* d = (uint2*)(sV + dv * 68 + c * 8); d[0] = (uint2){v[0], v[1]}; d[1] = (uint2){v[2], v[3]}; }
}
DI bf16x8 pack8(const f32x16& x, int s) {
  bf16x8 r;
#pragma unroll
  for (int j = 0; j < 8; ++j) r[j] = (short)f2bf(x[8 * s + j]);
  return r;
}
DI void pv_accum(const f32x16 (&s)[2], const bf16_t* sV, int r, int h, f32x16 (&O)[2]) {
#pragma unroll
  for (int t2 = 0; t2 < 2; ++t2)
#pragma unroll
    for (int s2 = 0; s2 < 2; ++s2) {
      const bf16x8 pf = pack8(s[t2], s2);
#pragma unroll
      for (int dt = 0; dt < 2; ++dt) {
        const bf16_t* vp = sV + (dt * 32 + r) * 68 + t2 * 32 + 16 * s2 + 4 * h;
        const s16x4 lo = *(const s16x4*)vp, hi = *(const s16x4*)(vp + 8);
        const bf16x8 vf = __builtin_shufflevector(lo, hi, 0, 1, 2, 3, 4, 5, 6, 7);
        O[dt] = MFMA32(vf, pf, O[dt]);
      }
    }
}
template <int DQK>
DI void attn_tile_step(const bf16_t* sK, const bf16_t* sV, const bf16x8 (&qf)[DQK / 16], int k0, int qpos, int window, float sl2, float& m, float& lsum, f32x16 (&O)[2], int r, int h) {
  constexpr int NKS = DQK / 16, LDK = DQK + 8;
  f32x16 s[2];
#pragma unroll
  for (int t2 = 0; t2 < 2; ++t2) {
#pragma unroll
    for (int i = 0; i < 16; ++i) s[t2][i] = 0.f;
#pragma unroll
    for (int ks = 0; ks < NKS; ++ks) { const bf16x8 a = *(const bf16x8*)(sK + (t2 * 32 + r) * LDK + ks * 16 + 8 * h); s[t2] = MFMA32(a, qf[ks], s[t2]); }
  }
  float mx = m;
#pragma unroll
  for (int t2 = 0; t2 < 2; ++t2)
#pragma unroll
    for (int i = 0; i < 16; ++i) { const int kpos = k0 + t2 * 32 + crow(i, h); const bool ok = (kpos <= qpos) && (window == 0 || qpos - kpos < window);
      const float v = ok ? s[t2][i] * sl2 : -1e30f; s[t2][i] = v; mx = fmaxf(mx, v); }
  mx = fmaxf(mx, __shfl_xor(mx, 32));
  const float corr = fexp2(m - mx); m = mx; float ps = 0.f;
#pragma unroll
  for (int t2 = 0; t2 < 2; ++t2)
#pragma unroll
    for (int i = 0; i < 16; ++i) { const float pv = (s[t2][i] > -1e29f) ? fexp2(s[t2][i] - mx) : 0.f; s[t2][i] = pv; ps += pv; }
  lsum = lsum * corr + ps;
#pragma unroll
  for (int dt = 0; dt < 2; ++dt)
#pragma unroll
    for (int i = 0; i < 16; ++i) O[dt][i] *= corr;
  pv_accum(s, sV, r, h, O);
}
DI void o_zero(f32x16 (&O)[2]) {
#pragma unroll
  for (int dt = 0; dt < 2; ++dt)
#pragma unroll
    for (int i = 0; i < 16; ++i) O[dt][i] = 0.f;
}
DI void o_finish(f32x16 (&O)[2], float lsum) {
  lsum += __shfl_xor(lsum, 32);
  const float inv = 1.f / lsum;
#pragma unroll
  for (int dt = 0; dt < 2; ++dt)
#pragma unroll
    for (int i = 0; i < 16; ++i) O[dt][i] *= inv;
}
DI void store_o(const f32x16 (&O)[2], bf16_t* dst  , int h) {
#pragma unroll
  for (int dt = 0; dt < 2; ++dt)
#pragma unroll
    for (int g = 0; g < 4; ++g) { uint2 pk; pk.x = pack2(O[dt][4 * g], O[dt][4 * g + 1]); pk.y = pack2(O[dt][4 * g + 2], O[dt][4 * g + 3]); *(uint2*)(dst + dt * 32 + 8 * g + 4 * h) = pk; }
}
DI void diff_item(const Params& p, int l, int b, int hh, int qb, char* smem) {
  const bf16_t* proj = (const bf16_t*)(p.ws + OFF_BIG) + (size_t)(b * S_) * LDP;
  const bf16_t* vt = (const bf16_t*)(p.ws + OFF_VT) + (size_t)(hh * 64) * VLD + b * S_;
  const int q0 = qb * 128, tid = tid_(), lane = tid & 63, wave = tid >> 6, r = lane & 31, h = lane >> 5, qw0 = q0 + wave * 32, qpos = qw0 + r;
  bf16_t* sK1 = (bf16_t*)smem; bf16_t* sK2 = sK1 + 64 * 40; bf16_t* sV = sK2 + 64 * 40;
  float d1 = 0.f, d2 = 0.f;
  for (int i = 0; i < 32; ++i) { d1 += p.lq1[l * 32 + i] * p.lk1[l * 32 + i]; d2 += p.lq2[l * 32 + i] * p.lk2[l * 32 + i]; }
  asm volatile("" : "+v"(d1), "+v"(d2));
  const float lam_init = 0.8f - 0.6f * expf(-0.3f * (float)l), lam = expf(d1) - expf(d2) + lam_init;
  const float sl2 = 0.17677669529663687f * 1.4426950408889634f;
  bf16x8 qf1[2], qf2[2];
#pragma unroll
  for (int ks = 0; ks < 2; ++ks) { qf1[ks] = *(const bf16x8*)(proj + (size_t)qpos * LDP + C_DQ1 + hh * 32 + ks * 16 + 8 * h); qf2[ks] = *(const bf16x8*)(proj + (size_t)qpos * LDP + C_DQ2 + hh * 32 + ks * 16 + 8 * h); }
  f32x16 O1[2], O2[2]; o_zero(O1); o_zero(O2);
  float m1 = -1e30f, m2 = -1e30f, l1 = 0.f, l2 = 0.f;
  const int kt1 = (q0 + 128) >> 6;
  const bf16_t* K1g = proj + C_DK1 + hh * 32; const bf16_t* K2g = proj + C_DK2 + hh * 32;
  KVRegs rg; rg.k[1] = (u32x4){0u, 0u, 0u, 0u}; uint4 rk2;
  kv_issue<32>(K1g, vt, 0, rg); rk2 = gld16(K2g + (size_t)(tid >> 2) * LDP + (tid & 3) * 8);
#pragma unroll 1
  for (int kt = 0; kt < kt1; ++kt) {
    const int k0 = kt * 64;
    kv_wait(rg); vm_wait0();
    __syncthreads();
    kv_commit<32>(rg, sK1, sV); *(uint4*)(sK2 + (tid >> 2) * 40 + (tid & 3) * 8) = rk2;
    __syncthreads();
    { const int kn = (kt + 1 < kt1 ? kt + 1 : kt) * 64; kv_issue<32>(K1g, vt, kn, rg); rk2 = gld16(K2g + (size_t)(kn + (tid >> 2)) * LDP + (tid & 3) * 8); }
    if (k0 > qw0 + 31) continue;
    attn_tile_step<32>(sK1, sV, qf1, k0, qpos, 0, sl2, m1, l1, O1, r, h);
    __builtin_amdgcn_sched_barrier(0);
    attn_tile_step<32>(sK2, sV, qf2, k0, qpos, 0, sl2, m2, l2, O2, r, h);
    __builtin_amdgcn_sched_barrier(0);
  }
  vm_wait0();
  o_finish(O1, l1); o_finish(O2, l2);
  float ss = 0.f;
#pragma unroll
  for (int dt = 0; dt < 2; ++dt)
#pragma unroll
    for (int i = 0; i < 16; ++i) { const float o = O1[dt][i] - lam * O2[dt][i]; O1[dt][i] = o; ss += o * o; }
  ss += __shfl_xor(ss, 32);
  const float rn = rsqrtf(ss * (1.f / 64.f) + 1e-6f) * (1.f - lam_init);
  int goff = l * 64 + 4 * h; asm volatile("" : "+v"(goff));
#pragma unroll
  for (int dt = 0; dt < 2; ++dt)
#pragma unroll
    for (int g = 0; g < 4; ++g) { const float4 gg = *(const float4*)(p.subln + goff + dt * 32 + 8 * g);
      O1[dt][4 * g] *= rn * gg.x; O1[dt][4 * g + 1] *= rn * gg.y; O1[dt][4 * g + 2] *= rn * gg.z; O1[dt][4 * g + 3] *= rn * gg.w; }
  bf16_t* mix = (bf16_t*)(p.ws + OFF_XB);
  store_o(O1, mix + (size_t)(b * S_ + qpos) * D_ + hh * 64, h);
}
DI void win_item(const Params& p, int b, int hh, int qb, char* smem) {
  const bf16_t* proj = (const bf16_t*)(p.ws + OFF_BIG) + (size_t)(b * S_) * LDP;
  const bf16_t* vt = (const bf16_t*)(p.ws + OFF_VT) + (size_t)(8 * 64) * VLD + b * S_;
  const int q0 = qb * 128, lane = tid_() & 63, wave = tid_() >> 6, r = lane & 31, h = lane >> 5, qw0 = q0 + wave * 32, qpos = qw0 + r;
  bf16_t* sK = (bf16_t*)smem; bf16_t* sV = sK + 64 * 72;
  int kt0 = (q0 >> 6) - 8; if (kt0 < 0) kt0 = 0;
  bf16x8 qf[4];
#pragma unroll
  for (int ks = 0; ks < 4; ++ks) qf[ks] = *(const bf16x8*)(proj + (size_t)qpos * LDP + C_NQ + hh * 64 + ks * 16 + 8 * h);
  f32x16 O[2]; o_zero(O);
  float m = -1e30f, lsum = 0.f;
  const int kt1 = (q0 + 128) >> 6;
  KVRegs rg; kv_issue<64>(proj + C_NKW, vt, kt0 * 64, rg);
#pragma unroll 1
  for (int kt = kt0; kt < kt1; ++kt) {
    const int k0 = kt * 64;
    kv_wait(rg);
    __syncthreads();
    kv_commit<64>(rg, sK, sV);
    __syncthreads();
    kv_issue<64>(proj + C_NKW, vt, (kt + 1 < kt1 ? kt + 1 : kt) * 64, rg);
    if (k0 > qw0 + 31) continue;
    if (k0 + 63 < qw0 - 511) continue;
    attn_tile_step<64>(sK, sV, qf, k0, qpos, 512, 0.125f * 1.4426950408889634f, m, lsum, O, r, h);
  }
  vm_wait0();
  o_finish(O, lsum);
  bf16_t* ow = (bf16_t*)(p.ws + OFF_OWIN);
  store_o(O, ow + (size_t)(b * S_ + qpos) * 256 + hh * 64, h);
}
DI void sb_item(const Params& p, int b, int hh, int qb, char* smem) {
  const bf16_t* proj = (const bf16_t*)(p.ws + OFF_BIG) + (size_t)(b * S_) * LDP;
  const bf16_t* Qb = proj + C_SQ + hh * 64; const bf16_t* Kb = proj + C_SK + hh * 64;
  const bf16_t* Vt = (const bf16_t*)(p.ws + OFF_VT) + (size_t)((4 + hh) * 64) * VLD + b * S_;
  bf16_t* sK = (bf16_t*)smem; bf16_t* sV = sK + 64 * 72;
  const int q0 = qb * 128, lane = tid_() & 63, wave = tid_() >> 6, r = lane & 31, h = lane >> 5;
  const int qw0 = q0 + wave * 32, qpos = qw0 + r;
  bf16x8 qf[4];
#pragma unroll
  for (int ks = 0; ks < 4; ++ks) qf[ks] = *(const bf16x8*)(Qb + (size_t)qpos * LDP + ks * 16 + 8 * h);
  f32x16 O[2];
#pragma unroll
  for (int dt = 0; dt < 2; ++dt)
#pragma unroll
    for (int i = 0; i < 16; ++i) O[dt][i] = 0.f;
  float R = 0.f;
  float* sflag = (float*)(smem + 20480);
  if (tid_() < 4) sflag[tid_()] = 0.f;
  KVRegs rg; kv_issue<64>(Kb, Vt, ((q0 + 127) >> 6) * 64, rg);
#pragma unroll 1
  for (int kt = (q0 + 127) >> 6; kt >= 0; --kt) {
    const int k0 = kt * 64;
    kv_wait(rg);
    __syncthreads();
    const float rmin = fminf(fminf(sflag[0], sflag[1]), fminf(sflag[2], sflag[3]));
    if (rmin > 90.f) break;
    kv_commit<64>(rg, sK, sV);
    __syncthreads();
    kv_issue<64>(Kb, Vt, (kt > 0 ? kt - 1 : 0) * 64, rg);
    if (k0 >= qw0 + 31) continue;
    { const float wmin = -wave_max(-R); if (wmin > 90.f) continue; }
    f32x16 s[2];
#pragma unroll
    for (int t2 = 0; t2 < 2; ++t2) {
#pragma unroll
      for (int i = 0; i < 16; ++i) s[t2][i] = 0.f;
#pragma unroll
      for (int ks = 0; ks < 4; ++ks) { const bf16x8 a = *(const bf16x8*)(sK + (t2 * 32 + r) * 72 + ks * 16 + 8 * h); s[t2] = MFMA32(a, qf[ks], s[t2]); }
    }
    float Tt = 0.f;
#pragma unroll
    for (int t2 = 1; t2 >= 0; --t2)
#pragma unroll
      for (int g = 3; g >= 0; --g) {
        float z[4], sp[4]; bool ok[4]; float gs = 0.f;
#pragma unroll
        for (int e = 0; e < 4; ++e) { const int kpos = k0 + t2 * 32 + 8 * g + 4 * h + e; ok[e] = kpos < qpos; z[e] = s[t2][4 * g + e] * 0.125f;
          const float spv = fmaxf(z[e], 0.f) + flog(1.f + fexp(-fabsf(z[e]))); sp[e] = ok[e] ? spv : 0.f; gs += sp[e]; }
        const float pg = __shfl_xor(gs, 32);
        float run = R + Tt + (h == 0 ? pg : 0.f);
#pragma unroll
        for (int e = 3; e >= 0; --e) { run += sp[e]; s[t2][4 * g + e] = ok[e] ? fexp(z[e] - run) : 0.f; }
        Tt += gs + pg;
      }
    R += Tt;
    { const float wmin = -wave_max(-R); if (lane == 0) sflag[wave] = wmin; }
    pv_accum(s, sV, r, h, O);
  }
  vm_wait0();
  bf16_t* mix = (bf16_t*)(p.ws + OFF_XB);
  store_o(O, mix + (size_t)(b * S_ + qpos) * D_ + 768 + hh * 64, h);
}

DI void gdn_chain(const Params& p, int item, char* smem) {
  const int b = item >> 4, hh = (item >> 2) & 3, sl = item & 3, tid = tid_(), c = tid >> 2, e4 = (tid & 3) * 4;
  float* sW = (float*)smem; float* sKD = sW + 64 * 65; float* sS = sKD + 64 * 65; float* sV = sS + 1024; float* sU = sV + 1024;
  float* U = (float*)(p.ws + OFF_GU_); const float* W = (const float*)(p.ws + OFF_GW); const float* KD = (const float*)(p.ws + OFF_GKD);
  float* Sg = (float*)(p.ws + OFF_GS); const float* glast = (const float*)(p.ws + OFF_GLAST);
  const int ch0 = (b * 4 + hh) * 128;
  __syncthreads();
  *(float4*)(sS + tid * 4) = (float4){0.f, 0.f, 0.f, 0.f};
  float4 rw[4], rk[4], ru;
  { const float4* wp = (const float4*)(W + (size_t)ch0 * 4096); const float4* kp = (const float4*)(KD + (size_t)ch0 * 4096);
#pragma unroll
    for (int i = 0; i < 4; ++i) { rw[i] = gldf4(wp + tid + 256 * i); rk[i] = gldf4(kp + tid + 256 * i); }
    ru = gldf4(U + (size_t)ch0 * 4096 + c * 64 + sl * 16 + e4); }
  for (int n = 0; n < 128; ++n) {
    const int ch = ch0 + n;
    vm_wait0();
    __syncthreads();
#pragma unroll
    for (int i = 0; i < 4; ++i) { const int idx = (tid + 256 * i) * 4, rr = idx >> 6, cc = idx & 63;
      float* dw = sW + rr * 65 + cc; dw[0] = rw[i].x; dw[1] = rw[i].y; dw[2] = rw[i].z; dw[3] = rw[i].w;
      float* dk = sKD + rr * 65 + cc; dk[0] = rk[i].x; dk[1] = rk[i].y; dk[2] = rk[i].z; dk[3] = rk[i].w; }
    *(float4*)(sU + c * 16 + e4) = ru;
    const float gl = glast[ch];
    __syncthreads();
    if (n + 1 < 128) { const float4* wp = (const float4*)(W + (size_t)(ch + 1) * 4096); const float4* kp = (const float4*)(KD + (size_t)(ch + 1) * 4096);
#pragma unroll
      for (int i = 0; i < 4; ++i) { rw[i] = gldf4(wp + tid + 256 * i); rk[i] = gldf4(kp + tid + 256 * i); }
      ru = gldf4(U + (size_t)(ch + 1) * 4096 + c * 64 + sl * 16 + e4); }
    float4 acc = *(const float4*)(sU + c * 16 + e4);
#pragma unroll 8
    for (int d = 0; d < 64; ++d) { const float wv = sW[c * 65 + d]; const float4 sv = *(const float4*)(sS + d * 16 + e4);
      acc.x -= wv * sv.x; acc.y -= wv * sv.y; acc.z -= wv * sv.z; acc.w -= wv * sv.w; }
    *(float4*)(sV + c * 16 + e4) = acc;
    *(float4*)(U + (size_t)ch * 4096 + c * 64 + sl * 16 + e4) = acc;
    float4 sold = *(const float4*)(sS + c * 16 + e4);
    *(float4*)(Sg + (size_t)ch * 4096 + c * 64 + sl * 16 + e4) = sold;
    __syncthreads();
    sold.x *= gl; sold.y *= gl; sold.z *= gl; sold.w *= gl;
#pragma unroll 8
    for (int cc = 0; cc < 64; ++cc) { const float kv = sKD[cc * 65 + c]; const float4 vv = *(const float4*)(sV + cc * 16 + e4);
      sold.x += kv * vv.x; sold.y += kv * vv.y; sold.z += kv * vv.z; sold.w += kv * vv.w; }
    *(float4*)(sS + c * 16 + e4) = sold;
  }
}
DI void gdn_g3(const Params& p, int l, int ch, char* smem) {
  const int b = ch >> 9, hh = (ch >> 7) & 3, n = ch & 127, s0 = n * 64, tid = tid_(), c = tid >> 2, part = tid & 3;
  float* B1 = (float*)smem; float* B2 = B1 + 64 * 68; float* B3 = B2 + 64 * 68; float* sG = B3 + 64 * 68; float* sBeta = sG + 64;
  const float* Vn = (const float*)(p.ws + OFF_GU_) + (size_t)ch * 4096; const float* Sg = (const float*)(p.ws + OFF_GS) + (size_t)ch * 4096;
  __syncthreads();
  gdn_gates(p, l, b, hh, s0, sG, sBeta);
  gdn_conv(p, l, b, hh, s0, 0, B1, 68, true, 0.125f);
  gdn_conv(p, l, b, hh, s0, 1, B2, 68, true, 1.f);
  __syncthreads();
  const float Gc = sG[c];
  for (int i = 0; i < 16; ++i) { const int s = part + 4 * i; float a = 0.f;
    if (s <= c) { float dot = 0.f;
#pragma unroll
      for (int d4 = 0; d4 < 16; ++d4) { const float4 x = *(const float4*)(B1 + c * 68 + 4 * d4), y = *(const float4*)(B2 + s * 68 + 4 * d4); dot += (x.x * y.x + x.y * y.y) + (x.z * y.z + x.w * y.w); }
      a = dot * expf(Gc - sG[s]); }
    B3[c * 68 + s] = a; }
  __syncthreads();
#pragma unroll
  for (int i = 0; i < 4; ++i) { const int idx = (tid + 256 * i) * 4, rr = idx >> 6, cc = idx & 63; const float4 v = *(const float4*)(Sg + idx);
    *(float4*)(B2 + rr * 68 + cc) = v; }
  __syncthreads();
  float acc[16];
#pragma unroll
  for (int e = 0; e < 16; ++e) acc[e] = 0.f;
#pragma unroll 2
  for (int d4 = 0; d4 < 16; ++d4) { const float4 q4 = *(const float4*)(B1 + c * 68 + 4 * d4); const float qv[4] = {q4.x, q4.y, q4.z, q4.w};
#pragma unroll
    for (int dd = 0; dd < 4; ++dd)
#pragma unroll
      for (int e4 = 0; e4 < 4; ++e4) { const float4 bv = *(const float4*)(B2 + (4 * d4 + dd) * 68 + part * 16 + 4 * e4);
        acc[4 * e4] += qv[dd] * bv.x; acc[4 * e4 + 1] += qv[dd] * bv.y; acc[4 * e4 + 2] += qv[dd] * bv.z; acc[4 * e4 + 3] += qv[dd] * bv.w; } }
  { const float eg = expf(Gc);
#pragma unroll
    for (int e = 0; e < 16; ++e) acc[e] *= eg; }
  __syncthreads();
#pragma unroll
  for (int i = 0; i < 4; ++i) { const int idx = (tid + 256 * i) * 4, rr = idx >> 6, cc = idx & 63; const float4 v = *(const float4*)(Vn + idx);
    *(float4*)(B2 + rr * 68 + cc) = v; }
  __syncthreads();
#pragma unroll 2
  for (int s4 = 0; s4 < 16; ++s4) { const float4 i4 = *(const float4*)(B3 + c * 68 + 4 * s4); const float iv[4] = {i4.x, i4.y, i4.z, i4.w};
#pragma unroll
    for (int dd = 0; dd < 4; ++dd)
#pragma unroll
      for (int e4 = 0; e4 < 4; ++e4) { const float4 bv = *(const float4*)(B2 + (4 * s4 + dd) * 68 + part * 16 + 4 * e4);
        acc[4 * e4] += iv[dd] * bv.x; acc[4 * e4 + 1] += iv[dd] * bv.y; acc[4 * e4 + 2] += iv[dd] * bv.z; acc[4 * e4 + 3] += iv[dd] * bv.w; } }
  float ss = 0.f;
#pragma unroll
  for (int e = 0; e < 16; ++e) ss += acc[e] * acc[e];
  ss += __shfl_xor(ss, 1); ss += __shfl_xor(ss, 2);
  const float rn = rsqrtf(ss * (1.f / 64.f) + 1e-6f);
  const size_t tok = (size_t)(b * S_ + s0 + c);
  const bf16_t* zr = (const bf16_t*)(p.ws + OFF_BIG) + tok * LDP + C_GZ + hh * 64 + part * 16;
  bf16_t* mix = (bf16_t*)(p.ws + OFF_XB) + tok * D_ + 256 + hh * 64 + part * 16;
#pragma unroll
  for (int e = 0; e < 16; e += 2) {
    const float z0 = bf2f(zr[e]), z1 = bf2f(zr[e + 1]);
    const float y0 = acc[e] * rn * p.gdng[l * 64 + part * 16 + e] * (z0 / (1.f + __expf(-z0)));
    const float y1 = acc[e + 1] * rn * p.gdng[l * 64 + part * 16 + e + 1] * (z1 / (1.f + __expf(-z1)));
    *(unsigned*)(mix + e) = pack2(y0, y1);
  }
}

DI void nsa_compress(const Params& p, int l, int item, char* smem) {
  const int b = item >> 7, kv = (item >> 6) & 1, grp = item & 63, c0 = grp * 8, tok0 = c0 * 16, tid = tid_(), lane = tid & 63, wv = tid >> 6;
  const bf16_t* proj = (const bf16_t*)(p.ws + OFF_BIG) + (size_t)(b * S_) * LDP + (kv ? C_NVC : C_NKC);
  bf16_t* X = (bf16_t*)smem;
  float* Hp = (float*)(smem + 18432);
  __syncthreads();
  for (int idx = tid; idx < 144 * 8; idx += 256) { const int tk = idx >> 3, c = idx & 7, si = tok0 + tk;
    uint4 v = {0u, 0u, 0u, 0u}; if (si < S_) v = *(const uint4*)(proj + (size_t)si * LDP + c * 8);
    *(uint4*)(X + tk * 64 + c * 8) = v; }
  __syncthreads();
  const float* w1 = (kv ? p.cvw1 : p.ckw1) + (size_t)l * 2048 * 256 + lane * 4; const float* pe = (kv ? p.pev : p.pek) + (size_t)l * 2048;
  float acc[8][4], bias[4] = {0.f, 0.f, 0.f, 0.f};
#pragma unroll
  for (int r = 0; r < 8; ++r) { acc[r][0] = 0.f; acc[r][1] = 0.f; acc[r][2] = 0.f; acc[r][3] = 0.f; }
  const int i0 = wv * 512;
  for (int ib = 0; ib < 512; ib += 8) {
    f32x4 wr[8];
#pragma unroll
    for (int u = 0; u < 8; ++u) wr[u] = gldfv(w1 + (size_t)(i0 + ib + u) * 256);
    asm volatile("s_waitcnt vmcnt(0)" : "+v"(wr[0]), "+v"(wr[1]), "+v"(wr[2]), "+v"(wr[3]), "+v"(wr[4]), "+v"(wr[5]), "+v"(wr[6]), "+v"(wr[7]) :: "memory");
#pragma unroll
    for (int u = 0; u < 8; ++u) { const int i = i0 + ib + u, tk = i >> 6, d = i & 63; const float pv = pe[i]; const f32x4 w = wr[u];
      bias[0] += pv * w[0]; bias[1] += pv * w[1]; bias[2] += pv * w[2]; bias[3] += pv * w[3];
#pragma unroll
      for (int r = 0; r < 8; ++r) { const float xv = bf2f(X[(16 * r + tk) * 64 + d]); acc[r][0] += xv * w[0]; acc[r][1] += xv * w[1]; acc[r][2] += xv * w[2]; acc[r][3] += xv * w[3]; } }
  }
#pragma unroll
  for (int r = 0; r < 8; ++r) *(float4*)(Hp + (wv * 8 + r) * 256 + lane * 4) = (float4){acc[r][0] + bias[0], acc[r][1] + bias[1], acc[r][2] + bias[2], acc[r][3] + bias[3]};
  __syncthreads();
#pragma unroll
  for (int q = 0; q < 8; ++q) { const int idx = tid + 256 * q; const float hv = Hp[idx] + Hp[2048 + idx] + Hp[4096 + idx] + Hp[6144 + idx]; Hp[idx] = hv / (1.f + __expf(-hv)); }
  __syncthreads();
  const float* H = Hp;
  const float* w2 = (kv ? p.cvw2 : p.ckw2) + (size_t)l * 256 * 64;
  const int r0 = tid >> 6, d = tid & 63; float o0 = 0.f, o1 = 0.f;
  for (int jb = 0; jb < 256; jb += 16) { float w[16];
#pragma unroll
    for (int u = 0; u < 16; ++u) w[u] = gld32(w2 + (jb + u) * 64 + d);
    asm volatile("s_waitcnt vmcnt(0)" : "+v"(w[0]), "+v"(w[1]), "+v"(w[2]), "+v"(w[3]), "+v"(w[4]), "+v"(w[5]), "+v"(w[6]), "+v"(w[7]), "+v"(w[8]), "+v"(w[9]), "+v"(w[10]), "+v"(w[11]), "+v"(w[12]), "+v"(w[13]), "+v"(w[14]), "+v"(w[15]) :: "memory");
#pragma unroll
    for (int u = 0; u < 16; ++u) { o0 += H[r0 * 256 + jb + u] * w[u]; o1 += H[(r0 + 4) * 256 + jb + u] * w[u]; } }
  bf16_t* dst = (bf16_t*)(p.ws + (kv ? OFF_VCMP : OFF_KCMP)) + (size_t)b * (kv ? 64 * CLD : 512 * 64);
  { const int c1 = c0 + r0, c2 = c0 + r0 + 4; const float v1 = c1 < 511 ? o0 : 0.f, v2 = c2 < 511 ? o1 : 0.f;
    if (kv) { dst[d * CLD + c1] = f2bf(v1); dst[d * CLD + c2] = f2bf(v2); } else { dst[c1 * 64 + d] = f2bf(v1); dst[c2 * 64 + d] = f2bf(v2); } }
}
struct SelRegs { u32x4 ka[2], kb[2], v[4]; };
DI void sel_issue(SelRegs& rg, const bf16_t* kbase  , int kld, const bf16_t* vtbase  , int vld, int rowa, int l15, int quad) {
#pragma unroll
  for (int ks = 0; ks < 2; ++ks) { rg.ka[ks] = gldv(kbase + (size_t)rowa * kld + ks * 32 + quad * 8); rg.kb[ks] = gldv(kbase + (size_t)(rowa + 4) * kld + ks * 32 + quad * 8); }
#pragma unroll
  for (int dt = 0; dt < 4; ++dt) rg.v[dt] = gldv(vtbase + (size_t)(dt * 16 + l15) * vld + 8 * quad);
}
DI void sel_wait(SelRegs& rg) {
  asm volatile("s_waitcnt vmcnt(0)" : "+v"(rg.ka[0]), "+v"(rg.ka[1]), "+v"(rg.kb[0]), "+v"(rg.kb[1]), "+v"(rg.v[0]), "+v"(rg.v[1]), "+v"(rg.v[2]), "+v"(rg.v[3]) :: "memory");
}
DI void sel_compute(const SelRegs& rg, const bf16x8 (&qf)[2], int kb0, bool colsel, int stk, int quad, float& m, float& lsum, f32x4 (&Os)[4]) {
  f32x4 sa = {0.f, 0.f, 0.f, 0.f}, sb = {0.f, 0.f, 0.f, 0.f};
#pragma unroll
  for (int ks = 0; ks < 2; ++ks) { sa = MFMA16(__builtin_bit_cast(bf16x8, rg.ka[ks]), qf[ks], sa); sb = MFMA16(__builtin_bit_cast(bf16x8, rg.kb[ks]), qf[ks], sb); }
  float mx = m;
#pragma unroll
  for (int i = 0; i < 4; ++i) { const int ka = kb0 + 8 * quad + i;
    const float va = (colsel && ka <= stk) ? sa[i] * 0.125f : -1e30f, vb = (colsel && ka + 4 <= stk) ? sb[i] * 0.125f : -1e30f;
    sa[i] = va; sb[i] = vb; mx = fmaxf(mx, fmaxf(va, vb)); }
  mx = fmaxf(mx, __shfl_xor(mx, 16)); mx = fmaxf(mx, __shfl_xor(mx, 32));
  const float corr = fexp(m - mx); m = mx; float ps = 0.f;
#pragma unroll
  for (int i = 0; i < 4; ++i) { const float pa = sa[i] > -1e29f ? fexp(sa[i] - mx) : 0.f, pb = sb[i] > -1e29f ? fexp(sb[i] - mx) : 0.f; sa[i] = pa; sb[i] = pb; ps += pa + pb; }
  lsum = lsum * corr + ps;
  bf16x8 pf;
#pragma unroll
  for (int i = 0; i < 4; ++i) { pf[i] = (short)f2bf(sa[i]); pf[4 + i] = (short)f2bf(sb[i]); }
#pragma unroll
  for (int dt = 0; dt < 4; ++dt) { Os[dt][0] *= corr; Os[dt][1] *= corr; Os[dt][2] *= corr; Os[dt][3] *= corr; Os[dt] = MFMA16(__builtin_bit_cast(bf16x8, rg.v[dt]), pf, Os[dt]); }
}
DI void nsa_group(const Params& p, int t0, float* wl) {
  const int lane = tid_() & 63, l15 = lane & 15, quad = lane >> 4, tk = l15 >> 2, hd = l15 & 3;
  const int b = t0 >> 13, s0 = t0 & (S_ - 1), cur = s0 >> 6, stk = s0 + tk;
  const bf16_t* projb = (const bf16_t*)(p.ws + OFF_BIG) + (size_t)(b * S_) * LDP;
  const bf16_t* kc = (const bf16_t*)(p.ws + OFF_KCMP) + (size_t)b * 512 * 64; const bf16_t* vcT = (const bf16_t*)(p.ws + OFF_VCMP) + (size_t)b * 64 * CLD;
  const bf16_t* vsT = (const bf16_t*)(p.ws + OFF_VT) + (size_t)(9 * 64) * VLD + b * S_;
  float* Gs = wl; float* Cs = wl + 4 * 132; int* blist = (int*)(wl + 8 * 132);
  WAVE_SYNC();
  for (int i = lane; i < 8 * 132; i += 64) wl[i] = 0.f;
  bf16x8 qf[2];
#pragma unroll
  for (int ks = 0; ks < 2; ++ks) qf[ks] = *(const bf16x8*)(projb + (size_t)stk * LDP + C_NQ + hd * 64 + ks * 32 + quad * 8);
  const int ncv = stk >= 31 ? ((stk - 31) >> 4) + 1 : 0, ncvmax = (s0 + 3 >= 31) ? ((s0 + 3 - 31) >> 4) + 1 : 0, nstep = (ncvmax + 31) >> 5;
  const int rowa = (l15 >> 2) * 8 + (l15 & 3);
  float m = -1e30f, lsum = 0.f;
  SelRegs c0r, c1r;
  f32x4 Oc[4];
#pragma unroll
  for (int dt = 0; dt < 4; ++dt) Oc[dt] = (f32x4){0.f, 0.f, 0.f, 0.f};
#define CMP_SCORES(rg_, cbase_) \
    f32x4 sa = {0.f, 0.f, 0.f, 0.f}, sb = {0.f, 0.f, 0.f, 0.f}; \
    _Pragma("unroll") for (int ks = 0; ks < 2; ++ks) { sa = MFMA16(__builtin_bit_cast(bf16x8, rg_.ka[ks]), qf[ks], sa); sb = MFMA16(__builtin_bit_cast(bf16x8, rg_.kb[ks]), qf[ks], sb); }
#define CMP_P1(rg_, cbase_) { CMP_SCORES(rg_, cbase_) float mx = m; \
    _Pragma("unroll") for (int i = 0; i < 4; ++i) { const int ca = (cbase_) + 8 * quad + i; const float va = ca < ncv ? sa[i] * 0.125f : -1e30f, vb = ca + 4 < ncv ? sb[i] * 0.125f : -1e30f; sa[i] = va; sb[i] = vb; mx = fmaxf(mx, fmaxf(va, vb)); } \
    mx = fmaxf(mx, __shfl_xor(mx, 16)); mx = fmaxf(mx, __shfl_xor(mx, 32)); \
    const float corr = fexp(m - mx); m = mx; float ps = 0.f; \
    _Pragma("unroll") for (int i = 0; i < 4; ++i) ps += (sa[i] > -1e29f ? fexp(sa[i] - mx) : 0.f) + (sb[i] > -1e29f ? fexp(sb[i] - mx) : 0.f); \
    lsum = lsum * corr + ps; }
#define CMP_P2(rg_, cbase_) { CMP_SCORES(rg_, cbase_) float ga = 0.f, gb = 0.f; \
    _Pragma("unroll") for (int i = 0; i < 4; ++i) { const int ca = (cbase_) + 8 * quad + i; const float pa = ca < ncv ? fexp(sa[i] * 0.125f - m) * inv : 0.f, pb = ca + 4 < ncv ? fexp(sb[i] * 0.125f - m) * inv : 0.f; \
      sa[i] = pa; sb[i] = pb; ga += pa; gb += pb; } \
    float ca3 = sa[3], cb3 = sb[3]; \
    ga += __shfl_xor(ga, 1); ga += __shfl_xor(ga, 2); gb += __shfl_xor(gb, 1); gb += __shfl_xor(gb, 2); \
    ca3 += __shfl_xor(ca3, 1); ca3 += __shfl_xor(ca3, 2); cb3 += __shfl_xor(cb3, 1); cb3 += __shfl_xor(cb3, 2); \
    if (hd == 0) { const int j = ((cbase_) >> 2) + 2 * quad; Gs[tk * 132 + j] = ga; Gs[tk * 132 + j + 1] = gb; Cs[tk * 132 + j + 1] = ca3; Cs[tk * 132 + j + 2] = cb3; } \
    bf16x8 pf; \
    _Pragma("unroll") for (int i = 0; i < 4; ++i) { pf[i] = (short)f2bf(sa[i]); pf[4 + i] = (short)f2bf(sb[i]); } \
    _Pragma("unroll") for (int dt = 0; dt < 4; ++dt) Oc[dt] = MFMA16(__builtin_bit_cast(bf16x8, rg_.v[dt]), pf, Oc[dt]); }
#define CMP_ISSUE(rg_, st_) sel_issue(rg_, kc + (size_t)((st_) * 32) * 64, 64, vcT + (st_) * 32, CLD, rowa, l15, quad)
  if (nstep > 0) {
    CMP_ISSUE(c0r, 0);
    for (int st = 0; st < nstep; st += 2) {
      sel_wait(c0r); CMP_ISSUE(c1r, (st + 1 < nstep ? st + 1 : st)); CMP_P1(c0r, st * 32)
      sel_wait(c1r); CMP_ISSUE(c0r, (st + 2 < nstep ? st + 2 : 0)); if (st + 1 < nstep) CMP_P1(c1r, (st + 1) * 32)
    }
    sel_wait(c0r);
  }
  lsum += __shfl_xor(lsum, 16); lsum += __shfl_xor(lsum, 32);
  const float inv = lsum > 0.f ? 1.f / lsum : 0.f;
  WAVE_SYNC();
  if (nstep > 0) {
    for (int st = 0; st < nstep; st += 2) {
      sel_wait(c0r); CMP_ISSUE(c1r, (st + 1 < nstep ? st + 1 : st)); CMP_P2(c0r, st * 32)
      sel_wait(c1r); CMP_ISSUE(c0r, (st + 2 < nstep ? st + 2 : st)); if (st + 1 < nstep) CMP_P2(c1r, (st + 1) * 32)
    }
    sel_wait(c0r);
  }
#undef CMP_SCORES
#undef CMP_P1
#undef CMP_P2
#undef CMP_ISSUE
  WAVE_SYNC();
  for (int i = lane; i < 512; i += 64) { const int t2 = i >> 7, j = i & 127; const bool valid = j <= cur, forced = valid && (j == 0 || j == cur || j == cur - 1);
    const float im = Gs[t2 * 132 + j] + Cs[t2 * 132 + j]; Gs[t2 * 132 + j] = forced ? 1e4f : (valid ? im : -1e4f); }
  WAVE_SYNC();
  unsigned long long mlo[4] = {0ull, 0ull, 0ull, 0ull}, mhi[4] = {0ull, 0ull, 0ull, 0ull};
  if (cur < 16) {
#pragma unroll
    for (int t2 = 0; t2 < 4; ++t2) mlo[t2] = (1ull << (cur + 1)) - 1ull;
  } else {
    const int tkr = lane >> 4, sub = lane & 15; float v[8]; int rank[8];
#pragma unroll
    for (int mm = 0; mm < 8; ++mm) { v[mm] = Gs[tkr * 132 + sub + 16 * mm]; rank[mm] = 0; }
#pragma unroll 8
    for (int j2 = 0; j2 <= cur; ++j2) { const float o = Gs[tkr * 132 + j2];
#pragma unroll
      for (int mm = 0; mm < 8; ++mm) rank[mm] += (o > v[mm] || (o == v[mm] && j2 < sub + 16 * mm)) ? 1 : 0; }
#pragma unroll
    for (int mm = 0; mm < 8; ++mm) { const unsigned long long bal = __ballot((sub + 16 * mm <= cur) && rank[mm] < 16);
#pragma unroll
      for (int t2 = 0; t2 < 4; ++t2) { const unsigned long long field = (bal >> (16 * t2)) & 0xffffull; if (mm < 4) mlo[t2] |= field << (16 * mm); else mhi[t2] |= field << (16 * (mm - 4)); } }
  }
  const unsigned long long ulo = mlo[0] | mlo[1] | mlo[2] | mlo[3], uhi = mhi[0] | mhi[1] | mhi[2] | mhi[3];
  const int nlo = __popcll(ulo), nblk = nlo + __popcll(uhi);
  { const unsigned long long below = (1ull << lane) - 1ull;
    if ((ulo >> lane) & 1ull) { int tm = 0;
#pragma unroll
      for (int t2 = 0; t2 < 4; ++t2) tm |= (int)((mlo[t2] >> lane) & 1ull) << t2;
      blist[__popcll(ulo & below)] = lane | (tm << 8); }
    if ((uhi >> lane) & 1ull) { int tm = 0;
#pragma unroll
      for (int t2 = 0; t2 < 4; ++t2) tm |= (int)((mhi[t2] >> lane) & 1ull) << t2;
      blist[nlo + __popcll(uhi & below)] = (lane + 64) | (tm << 8); } }
  WAVE_SYNC();
  float m2 = -1e30f, l2 = 0.f; f32x4 Os[4];
#pragma unroll
  for (int dt = 0; dt < 4; ++dt) Os[dt] = (f32x4){0.f, 0.f, 0.f, 0.f};
  const int nh = 2 * nblk;
  SelRegs r0, r1;
  { const int e0 = __builtin_amdgcn_readfirstlane(blist[0]); sel_issue(r0, projb + (size_t)((e0 & 255) * 64) * LDP + C_NKS, LDP, vsT + (e0 & 255) * 64, VLD, rowa, l15, quad); }
  for (int hs = 0; hs < nh; hs += 2) {
    const int e = __builtin_amdgcn_readfirstlane(blist[hs >> 1]); const int kb0 = (e & 255) * 64; const bool colsel = ((e >> (8 + tk)) & 1) != 0;
    sel_wait(r0);
    sel_issue(r1, projb + (size_t)(kb0 + 32) * LDP + C_NKS, LDP, vsT + kb0 + 32, VLD, rowa, l15, quad);
    sel_compute(r0, qf, kb0, colsel, stk, quad, m2, l2, Os);
    sel_wait(r1);
    { const int en = __builtin_amdgcn_readfirstlane(blist[(hs + 2 < nh ? hs + 2 : hs) >> 1]); sel_issue(r0, projb + (size_t)((en & 255) * 64) * LDP + C_NKS, LDP, vsT + (en & 255) * 64, VLD, rowa, l15, quad); }
    sel_compute(r1, qf, kb0 + 32, colsel, stk, quad, m2, l2, Os);
  }
  sel_wait(r0);
  l2 += __shfl_xor(l2, 16); l2 += __shfl_xor(l2, 32);
  const float inv2 = 1.f / l2;
  const size_t tok = (size_t)(b * S_ + stk);
  const bf16_t* prow = projb + (size_t)stk * LDP;
  const float g0 = 1.f / (1.f + __expf(-bf2f(prow[C_NG + hd * 3]))), g1 = 1.f / (1.f + __expf(-bf2f(prow[C_NG + hd * 3 + 1]))), g2 = 1.f / (1.f + __expf(-bf2f(prow[C_NG + hd * 3 + 2])));
  const bf16_t* ow = (const bf16_t*)(p.ws + OFF_OWIN) + tok * 256 + hd * 64; bf16_t* mix = (bf16_t*)(p.ws + OFF_XB) + tok * D_ + 512 + hd * 64;
#pragma unroll
  for (int dt = 0; dt < 4; ++dt) { const int dv = dt * 16 + 4 * quad; const uint2 wv = *(const uint2*)(ow + dv);
    const float w0 = __uint_as_float(wv.x << 16), w1 = __uint_as_float(wv.x & 0xffff0000u), w2 = __uint_as_float(wv.y << 16), w3 = __uint_as_float(wv.y & 0xffff0000u);
    uint2 pk; pk.x = pack2(g0 * Oc[dt][0] + g1 * Os[dt][0] * inv2 + g2 * w0, g0 * Oc[dt][1] + g1 * Os[dt][1] * inv2 + g2 * w1);
    pk.y = pack2(g0 * Oc[dt][2] + g1 * Os[dt][2] * inv2 + g2 * w2, g0 * Oc[dt][3] + g1 * Os[dt][3] * inv2 + g2 * w3);
    *(uint2*)(mix + dv) = pk; }
}

DI int q_pop(unsigned* ctr, char* smem) {
  int* sh = (int*)(smem + 65024);
  __syncthreads();
  if (tid_() == 0) *sh = (int)atomicAdd(ctr, 1u);
  __syncthreads();
  return *sh;
}
DI void m1_phase(const Params& p, int l, char* smem, int cslot = 0, int skip = 0) {
  unsigned* ctr = (unsigned*)(p.ws + OFF_CNT) + cslot;
  const int total = 32 + 64 * 24 + 256;
  bool first = true;
  for (;;) {
    const int it = (first ? (int)blockIdx.x : q_pop(ctr, smem) + (int)gridDim.x) + skip; first = false;
    if (it >= total) break;
#ifndef M1SEL
#define M1SEL 31
#endif
    if (it < 32) { if (M1SEL & 1) gdn_chain(p, it, smem); }
    else if (it < 32 + 256) { if (M1SEL & 16) nsa_compress(p, l, it - 32, smem); }
    else { const int j = it - 288, kind = j >> 9, jj = j & 511, qb = 63 - (jj >> 3), bh = jj & 7, b = bh >> 2, hh = bh & 3;
      if (kind == 0) { if (M1SEL & 4) diff_item(p, l, b, hh, qb, smem); } else if (kind == 1) { if (M1SEL & 8) win_item(p, b, hh, qb, smem); } else { if (M1SEL & 2) sb_item(p, b, hh, qb, smem); } }
  }
}
DI void m2_phase(const Params& p, int l, char* smem, int cslot = 16) {
  unsigned* ctr = (unsigned*)(p.ws + OFF_CNT) + cslot;
  const int total = 2048, wave = tid_() >> 6;
  bool first = true;
  for (;;) {
    const int it = first ? (int)blockIdx.x : q_pop(ctr, smem) + (int)gridDim.x; first = false;
    if (it >= total) break;
    if (it < 1024) nsa_group(p, (1023 - it) * 16 + wave * 4, (float*)smem + wave * 1152);
    else gdn_g3(p, l, it - 1024, smem);
  }
}

struct XB { unsigned x, nloc, nx; };
#define XB_XCNT(j) (64 * (j))
#define XB_XSUB(j) (64 * (16 + (j)))
#define XB_XGEN(j) (64 * (32 + (j)))
#define XB_TOP (64 * 48)
#define XB_TOPGEN (64 * 49)
DI unsigned xb_ld(unsigned* p) { return __hip_atomic_load(p, __ATOMIC_RELAXED, __HIP_MEMORY_SCOPE_AGENT); }
DI unsigned xb_add(unsigned* p, unsigned v) { return __hip_atomic_fetch_add(p, v, __ATOMIC_RELAXED, __HIP_MEMORY_SCOPE_AGENT); }
DI unsigned xb_xcc_id() { return (unsigned)__builtin_amdgcn_s_getreg((3 << 11) | 20) & 0xFu; }
#define XB_SPIN(cond) do { unsigned sp_ = 0; while ((cond) && ++sp_ < (1u << 24)) __builtin_amdgcn_s_sleep(1); } while (0)
DI void xcd_barrier(unsigned* bar, const XB& b) {
  asm volatile("s_waitcnt vmcnt(0)" ::: "memory");
  __syncthreads();
  if (tid_() == 0) {
    asm volatile("s_waitcnt vmcnt(0) lgkmcnt(0)" ::: "memory");
    const unsigned old = xb_add(bar + XB_XSUB(b.x), 1u), gen = old / b.nloc;
    if (old + 1u == (gen + 1u) * b.nloc) {
      __builtin_amdgcn_fence(__ATOMIC_RELEASE, "agent");
      asm volatile("s_waitcnt vmcnt(0)" ::: "memory");
      const unsigned og = xb_add(bar + XB_TOP, 1u), tg = og / b.nx;
      if (og + 1u == (tg + 1u) * b.nx) xb_add(bar + XB_TOPGEN, 1u);
      else XB_SPIN(xb_ld(bar + XB_TOPGEN) == tg);
      __builtin_amdgcn_fence(__ATOMIC_ACQUIRE, "agent");
      xb_add(bar + XB_XGEN(b.x), 1u);
      asm volatile("s_waitcnt vmcnt(0)" ::: "memory");
    } else {
      XB_SPIN(xb_ld(bar + XB_XGEN(b.x)) == gen);
      __builtin_amdgcn_fence(__ATOMIC_ACQUIRE, "agent");
      asm volatile("s_waitcnt vmcnt(0)" ::: "memory");
    }
  }
  __syncthreads();
}
constexpr int NPHASE = 25;
DI void run_phase(const Params& p, int ph, char* smem) {
  if (ph == 0) { prologue_phase(p); convert_weights(p, 0, 1, smem); return; }
  const int l = (ph - 1) / 12, sp = (ph - 1) % 12;
  const float alpha = 1.4142135623730951f;
  bf16_t* xb = (bf16_t*)(p.ws + OFF_XB); bf16_t* big = (bf16_t*)(p.ws + OFF_BIG);
  const bf16_t* wgu = (const bf16_t*)(p.ws + OFF_GU); const bf16_t* wdn = (const bf16_t*)(p.ws + OFF_DN);
  EpiArgs e; e.obf = big; e.resid = p.out; e.of32 = p.out; e.alpha = alpha; e.sc = 0.5f; e.rope = (const float*)(p.ws + OFF_ROPE);
  switch (sp) {
    case 0: case 9: gemm_phase<0>(xb, D_, wgu, D_, 2 * DFF, smem, e); break;
    case 1: if (l == 0) e.resid = p.x; gemm_phase<2>(big, DFF, wdn, DFF, D_, smem, e); break;
    case 10: gemm_phase<2>(big, DFF, wdn, DFF, D_, smem, e); break;
    case 2: ln_phase(p.out, xb, p.ln1g + l * D_, p.ln1b + l * D_); break;
    case 3: gemm_phase<1>(xb, D_, (const bf16_t*)(p.ws + OFF_WIN), D_, LDP, smem, e); break;
    case 4: m0_phase(p, l, smem); break;
    case 5: m1_phase(p, l, smem); break;
    case 6: m2_phase(p, l, smem); break;
    case 7: e.sc = 1.f; gemm_phase<2>(xb, D_, (const bf16_t*)(p.ws + OFF_WOUT), D_, D_, smem, e); break;
    case 8: ln_phase(p.out, xb, p.ln2g + l * D_, p.ln2b + l * D_); convert_weights(p, l, 2, smem); break;
    case 11: ln_phase(p.out, xb, p.ln3g + l * D_, p.ln3b + l * D_); if (l + 1 < 2) convert_weights(p, l + 1, 1, smem); break;
  }
}
__global__ void __launch_bounds__(256, 2) mega(Params p, int ph0, int ph1, int coop) {
  __shared__ __attribute__((aligned(16))) char smem[65536];
#ifdef PHASE_ONLY
  run_phase(p, PHASE_ONLY, smem); return;
#endif
  XB xb; xb.x = xb_xcc_id(); xb.nloc = 1u; xb.nx = 1u;
  unsigned* bar = (unsigned*)(p.ws + OFF_BAR);
  if (coop && tid_() == 0) xb_add(bar + XB_XCNT(xb.x), 1u);
  for (int ph = ph0; ph < ph1; ++ph) {
    const Params& q = p;
    run_phase(q, ph, smem);
#ifdef PROBE_DUP
    { const int sp = (ph - 1) % 12; const int l = (ph - 1) / 12;
      if (ph > 0 && PROBE_DUP == 1 && (sp == 0 || sp == 9)) { cg::this_grid().sync(); run_phase(q, ph, smem); }
      if (ph > 0 && PROBE_DUP == 2 && sp == 5) { cg::this_grid().sync(); m1_phase(q, l, smem, 32, 32); }
      if (ph > 0 && PROBE_DUP == 3 && sp == 6) { cg::this_grid().sync(); m2_phase(q, l, smem, 48); }
      if (ph > 0 && PROBE_DUP == 6 && sp == 6) { cg::this_grid().sync(); for (int it = blockIdx.x; it < 1024; it += gridDim.x) gdn_g3(q, l, it, smem); }
      if (ph > 0 && PROBE_DUP == 7 && sp == 4) { cg::this_grid().sync(); for (int it = blockIdx.x; it < 2560; it += gridDim.x) vt_tile(q, it, smem); }
      if (PROBE_DUP == 8 && ph < 20) { cg::this_grid().sync(); cg::this_grid().sync(); }
      if (ph > 0 && PROBE_DUP == 4 && sp == 3) { cg::this_grid().sync(); run_phase(q, ph, smem); }
      if (ph > 0 && PROBE_DUP == 5 && sp == 4) { cg::this_grid().sync(); for (int it = blockIdx.x; it < 2560 + 1024; it += gridDim.x) { if (it < 1024) gdn_g1(q, l, it, smem); else vt_tile(q, it - 1024, smem); } } }
#endif
    if (coop && ph + 1 < ph1) {
      if (ph == 0) { cg::this_grid().sync();
        unsigned mine = 0u, cnt = 0u;
        for (unsigned j = 0; j < 16; ++j) { const unsigned c = xb_ld(bar + XB_XCNT(j)); cnt += c > 0u ? 1u : 0u; mine = (j == xb.x) ? c : mine; }
        xb.nloc = mine > 0u ? mine : 1u; xb.nx = cnt > 0u ? cnt : 1u; }
      else xcd_barrier(bar, xb);
    }
  }
}

extern "C" void kernel_launch(void* const* d_in, const int* in_sizes, int n_in, void* d_out, int out_size, void* d_ws, size_t ws_size, hipStream_t stream) {
  Params p{};
  const float** f = (const float**)&p;
  for (int i = 0; i < 28; ++i) f[i] = (const float*)d_in[i];
  p.out = (float*)d_out; p.ws = (char*)d_ws;
  static int grid_blocks = 0;
  if (!grid_blocks) {
    int dev = 0, cus = 0, per_cu = 0;
    hipGetDevice(&dev);
    hipDeviceGetAttribute(&cus, hipDeviceAttributeMultiprocessorCount, dev);
    hipOccupancyMaxActiveBlocksPerMultiprocessor(&per_cu, mega, 256, 0);
    if (per_cu < 1) per_cu = 1;
    if (per_cu > 2) per_cu = 2;
    grid_blocks = cus * per_cu;
  }
  if (ws_size < WS_NEED) { fprintf(stderr, "workspace too small: %zu < %zu\n", ws_size, (size_t)WS_NEED); return; }
#if MK_COOP
  hipMemsetAsync((char*)d_ws + OFF_BAR, 0, 32768, stream);
  int ph0 = 0, ph1 = NPHASE, coop = 1;
  void* args[] = {&p, &ph0, &ph1, &coop};
  hipError_t e = hipLaunchCooperativeKernel((void*)mega, dim3(grid_blocks), dim3(256), args, 0, stream);
  if (e != hipSuccess) fprintf(stderr, "cooperative launch failed: %s (grid %d)\n", hipGetErrorString(e), grid_blocks);
#else
  for (int ph = 0; ph < NPHASE; ++ph) hipLaunchKernelGGL(mega, dim3(grid_blocks), dim3(256), 0, stream, p, ph, ph + 1, 0);
#endif
}
```
